# Optimizing an MI355X kernel written in HIP

```python
import math
import jax, jax.numpy as jnp
from jax import lax
import numpy as np

D_MODEL = 1024
BATCH = 4
SEQ = 4096
DEPTH = 4

GRID_W = 64
CTX_LEN = 256
D_MIX = D_MODEL
HEAD_DIM = 64
D_ATT = D_MIX // 4
D_RWKV = D_MIX // 4
D_POOL = D_MIX // 4
D_FOUR = D_MIX - D_ATT - D_RWKV - D_POOL
N_Q_HEADS = D_ATT // HEAD_DIM
N_KV_HEADS = 2
D_KV = N_KV_HEADS * HEAD_DIM
N_RWKV_HEADS = D_RWKV // HEAD_DIM
POOL_WINDOWS = (2, 4, 8, 16)
N_POOL_GROUPS = 4
POOL_GROUP = D_POOL // N_POOL_GROUPS
N_FOUR_GROUPS = 4
FOUR_GROUP = D_FOUR // N_FOUR_GROUPS
DECAY_RANK = 32
ICL_RANK = 32
GATE_RANK = 64
D_FF = 2816
Q_BLOCK = 128
ROPE_THETA = 10000.0
LN_EPS = 1e-5
QK_EPS = 1e-6
GN_EPS = 64e-5
N_SUB = 3
DEEPNORM_ALPHA = (2 * DEPTH) ** 0.25
DEEPNORM_BETA = (8 * DEPTH) ** -0.25
SPLIT_SIZES = (D_ATT, D_KV, D_KV, D_RWKV, D_RWKV, D_RWKV, D_RWKV, D_POOL, D_FOUR)
D_IN = D_ATT + 2 * D_KV + 4 * D_RWKV + D_POOL + D_FOUR

kernel_name = "hybrid_headgroup_dit_block"

F32 = jnp.float32


def _split_points():
    pts, acc = [], 0
    for s in SPLIT_SIZES[:-1]:
        acc += s
        pts.append(acc)
    return pts


def layer_norm(x, g, b):
    x32 = x.astype(F32)
    mu = jnp.mean(x32, -1, keepdims=True)
    var = jnp.mean(jnp.square(x32 - mu), -1, keepdims=True)
    return ((x32 - mu) * lax.rsqrt(var + LN_EPS) * g + b).astype(x.dtype)


def modulate(x, shift, scale):
    return x * (1 + scale) + shift


def post_norm(x, y, gate, g, b, resid_w):
    return layer_norm(DEEPNORM_ALPHA * x + resid_w * gate * y, g, b)


def swiglu(h, w_gu, w_dn):
    gate, up = jnp.split(h @ w_gu, 2, axis=-1)
    return (jax.nn.silu(gate) * up) @ w_dn


def head_rms(x, g):
    x32 = x.astype(F32)
    return (x32 * lax.rsqrt(jnp.mean(jnp.square(x32), -1, keepdims=True) + QK_EPS) * g).astype(x.dtype)


def axial_rope(T):
    n_rows = T // GRID_W
    rows = jnp.repeat(jnp.arange(n_rows), GRID_W).astype(F32)
    cols = jnp.tile(jnp.arange(GRID_W), n_rows).astype(F32)
    n_pair_axis = HEAD_DIM // 4
    inv = ROPE_THETA ** (-jnp.arange(n_pair_axis, dtype=F32) / n_pair_axis)
    ang = jnp.concatenate([rows[:, None] * inv, cols[:, None] * inv], -1)
    return jnp.cos(ang), jnp.sin(ang)


def apply_rope(x, cos, sin):
    B, T, H, dh = x.shape
    xp = x.astype(F32).reshape(B, T, H, dh // 2, 2)
    x0, x1 = xp[..., 0], xp[..., 1]
    c = cos[None, :, None, :]
    s = sin[None, :, None, :]
    out = jnp.stack([x0 * c - x1 * s, x0 * s + x1 * c], -1).reshape(B, T, H, dh)
    return out.astype(x.dtype)


def attend(q, k, v):
    B, S, Hq, dh = q.shape
    Hkv = k.shape[2]
    G = Hq // Hkv
    nb = S // Q_BLOCK
    qb = jnp.moveaxis(q.reshape(B, nb, Q_BLOCK, Hkv, G, dh), 1, 0)
    scale = dh ** -0.5

    def block(qblk):
        s = jnp.einsum('bqhgd,bkhd->bhgqk', qblk, k).astype(F32) * scale
        p = jax.nn.softmax(s, axis=-1).astype(v.dtype)
        return jnp.einsum('bhgqk,bkhd->bqhgd', p, v)

    o = lax.map(block, qb)
    return jnp.moveaxis(o, 0, 1).reshape(B, S, Hq * dh)


def attn_heads(zq, zk, zv, qg, kg):
    B, T, _ = zq.shape
    q = head_rms(zq.reshape(B, T, N_Q_HEADS, HEAD_DIM), qg)
    k = head_rms(zk.reshape(B, T, N_KV_HEADS, HEAD_DIM), kg)
    v = zv.reshape(B, T, N_KV_HEADS, HEAD_DIM)
    return q, k, v


def centred_shift(z):
    zp = jnp.pad(z, ((0, 0), (1, 1), (0, 0)))
    return 0.5 * (zp[:, :-2] + zp[:, 2:])


def rwkv_heads(t):
    B, T, _ = t.shape
    return t.reshape(B, T, N_RWKV_HEADS, HEAD_DIM)


def rwkv_prepare(z_r, z_k, z_v, z_u, p):
    mu = p['rwkv_mu']
    r = z_r + (centred_shift(z_r) - z_r) * mu[0]
    k = z_k + (centred_shift(z_k) - z_k) * mu[1]
    v = z_v + (centred_shift(z_v) - z_v) * mu[2]
    du = centred_shift(z_u) - z_u
    xw = z_u + du * mu[3]
    xa = z_u + du * mu[4]
    xg = z_u + du * mu[5]
    g = jax.nn.sigmoid(xg @ p['gate_g1']) @ p['gate_g2']
    kk = rwkv_heads(k * p['k_k']).astype(F32)
    kk = kk / jnp.maximum(jnp.sqrt(jnp.sum(jnp.square(kk), -1, keepdims=True)), 1e-12)
    dirs = []
    for d in range(2):
        w_raw = (p['decay_w0'][d] + jnp.tanh(xw @ p['decay_w1'][d]) @ p['decay_w2'][d]).astype(F32)
        decay = jnp.exp(-jnp.exp(-jax.nn.softplus(-w_raw) - 0.5))
        a = jax.nn.sigmoid(p['icl_a0'][d] + (xa @ p['icl_a1'][d]) @ p['icl_a2'][d])
        kd = k * (1 + (a - 1) * p['k_a'])
        dirs.append((rwkv_heads(decay), rwkv_heads(kd), rwkv_heads(a)))
    return rwkv_heads(r), rwkv_heads(v), kk, g, dirs


def wkv_scan(S0, r, w, k, v, a, b, reverse, emit):
    def step(S, inp):
        r_t, w_t, k_t, v_t, a_t, b_t = inp
        sa = jnp.einsum('bhvk,bhk->bhv', S, a_t)
        S = S * w_t[:, :, None, :] + sa[..., None] * b_t[:, :, None, :] + v_t[..., None] * k_t[:, :, None, :]
        y = jnp.einsum('bhvk,bhk->bhv', S, r_t) if emit else None
        return S, y

    xs = tuple(jnp.moveaxis(t.astype(F32), 1, 0) for t in (r, w, k, v, a, b))
    S_final, ys = lax.scan(step, S0, xs, reverse=reverse)
    return (jnp.moveaxis(ys, 0, 1) if emit else None), S_final


def rwkv_mix(feats, S0s, p, emit):
    r, v, kk, g, dirs = feats
    ys, bonus, finals = [], [], []
    for d, (w, kd, a) in enumerate(dirs):
        y, Sf = wkv_scan(S0s[d], r, w, kd, v, -kk, kk * a, reverse=(d == 1), emit=emit)
        finals.append(Sf)
        if emit:
            ys.append(y)
            bonus.append(jnp.sum(r * kd * p['r_k'], -1, keepdims=True).astype(F32) * v.astype(F32))
    if not emit:
        return None, finals
    B, T = r.shape[0], r.shape[1]
    y = ys[0] + ys[1]
    mu = jnp.mean(y, -1, keepdims=True)
    var = jnp.mean(jnp.square(y - mu), -1, keepdims=True)
    yn = ((y - mu) * lax.rsqrt(var + GN_EPS)).reshape(B, T, D_RWKV) * p['gn_g'] + p['gn_b']
    out = (yn + (bonus[0] + bonus[1]).reshape(B, T, D_RWKV)) * g
    return out.astype(g.dtype), finals


def centred_window_mean(z, win):
    B, T, C = z.shape
    cs = jnp.concatenate([jnp.zeros((B, 1, C), F32), jnp.cumsum(z.astype(F32), axis=1)], axis=1)
    t = jnp.arange(T)
    lo = jnp.clip(t - win // 2, 0, T)
    hi = jnp.clip(t + (win - win // 2), 0, T)
    cnt = (hi - lo).astype(F32)
    return (cs[:, hi] - cs[:, lo]) / cnt[None, :, None]


def pool_mix(z, p):
    B, T, _ = z.shape
    groups = jnp.split(z, N_POOL_GROUPS, axis=-1)
    pooled = jnp.stack([centred_window_mean(zg, w) - zg.astype(F32) for zg, w in zip(groups, POOL_WINDOWS)], axis=2)
    y = jnp.einsum('btgc,gcd->btgd', pooled.astype(z.dtype), p['pool_w']).reshape(B, T, D_POOL)
    return y * p['pool_scale']


def fourier_mix(z, p):
    B, T, _ = z.shape
    zg = z.astype(F32).reshape(B, T, N_FOUR_GROUPS, FOUR_GROUP)
    f = jnp.fft.fft2(zg, axes=(1, 3), norm='ortho').real.astype(z.dtype).reshape(B, T, D_FOUR)
    return f @ p['fourier_w']


def mixer(hl, hc, p, ctx_out):
    pts = _split_points()
    zl = jnp.split(hl @ p['w_in'], pts, axis=-1)
    zc = jnp.split(hc @ p['w_in'], pts, axis=-1)
    B = hl.shape[0]
    ql, kl, vl = attn_heads(zl[0], zl[1], zl[2], p['q_norm_g'], p['k_norm_g'])
    qc, kc, vc = attn_heads(zc[0], zc[1], zc[2], p['q_norm_g'], p['k_norm_g'])
    cos, sin = axial_rope(hl.shape[1])
    ql = apply_rope(ql, cos, sin)
    kl = apply_rope(kl, cos, sin)
    att_l = attend(ql, jnp.concatenate([kc, kl], 1), jnp.concatenate([vc, vl], 1))
    zero = jnp.zeros((B, N_RWKV_HEADS, HEAD_DIM, HEAD_DIM), F32)
    rw_c, finals = rwkv_mix(rwkv_prepare(zc[3], zc[4], zc[5], zc[6], p), (zero, zero), p, emit=ctx_out)
    rw_l, _ = rwkv_mix(rwkv_prepare(zl[3], zl[4], zl[5], zl[6], p), finals, p, emit=True)
    out_l = jnp.concatenate([att_l, rw_l, pool_mix(zl[7], p), fourier_mix(zl[8], p)], -1) @ p['w_out']
    if not ctx_out:
        return out_l, None
    att_c = attend(qc, kc, vc)
    out_c = jnp.concatenate([att_c, rw_c, pool_mix(zc[7], p), fourier_mix(zc[8], p)], -1) @ p['w_out']
    return out_l, out_c


def setup_inputs(seed: int = 0) -> dict:
    key = jax.random.key(seed)
    ks = jax.random.split(key, 40)
    L = DEPTH

    def nrm(k, shape, scale):
        return jax.random.normal(k, shape, F32) * scale

    return {
        'x': nrm(ks[0], (BATCH, SEQ, D_MODEL), 1.0),
        'c': nrm(ks[1], (BATCH, D_MODEL), 1.0),
        'ctx': nrm(ks[2], (BATCH, CTX_LEN, D_MODEL), 1.0),
        'c_ctx': nrm(ks[3], (D_MODEL,), 1.0),
        'w_mod': nrm(ks[4], (L, D_MODEL, N_SUB * 3 * D_MODEL), 0.5 * D_MODEL ** -0.5),
        'b_mod': nrm(ks[5], (L, N_SUB * 3 * D_MODEL), 0.01),
        'ln_g': 1.0 + nrm(ks[6], (L, N_SUB, D_MODEL), 0.01),
        'ln_b': nrm(ks[7], (L, N_SUB, D_MODEL), 0.01),
        'w_ffn_in': nrm(ks[8], (L, 2, D_MODEL, 2 * D_FF), D_MODEL ** -0.5),
        'w_ffn_out': nrm(ks[9], (L, 2, D_FF, D_MODEL), DEEPNORM_BETA * D_FF ** -0.5),
        'w_in': nrm(ks[10], (L, D_MODEL, D_IN), D_MODEL ** -0.5),
        'q_norm_g': 1.0 + nrm(ks[11], (L, HEAD_DIM), 0.01),
        'k_norm_g': 1.0 + nrm(ks[12], (L, HEAD_DIM), 0.01),
        'rwkv_mu': jax.random.uniform(ks[13], (L, 6, D_RWKV), F32),
        'decay_w0': jax.random.uniform(ks[14], (L, 2, D_RWKV), F32, -6.5, -1.0),
        'decay_w1': nrm(ks[15], (L, 2, D_RWKV, DECAY_RANK), 0.1 * D_RWKV ** -0.5),
        'decay_w2': nrm(ks[16], (L, 2, DECAY_RANK, D_RWKV), 0.1 * DECAY_RANK ** -0.5),
        'icl_a0': nrm(ks[17], (L, 2, D_RWKV), 0.1),
        'icl_a1': nrm(ks[18], (L, 2, D_RWKV, ICL_RANK), D_RWKV ** -0.5),
        'icl_a2': nrm(ks[19], (L, 2, ICL_RANK, D_RWKV), ICL_RANK ** -0.5),
        'gate_g1': nrm(ks[20], (L, D_RWKV, GATE_RANK), D_RWKV ** -0.5),
        'gate_g2': nrm(ks[21], (L, GATE_RANK, D_RWKV), GATE_RANK ** -0.5),
        'k_k': 0.85 + nrm(ks[22], (L, D_RWKV), 0.02),
        'k_a': 1.0 + nrm(ks[23], (L, D_RWKV), 0.02),
        'r_k': nrm(ks[24], (L, N_RWKV_HEADS, HEAD_DIM), 0.1),
        'gn_g': 1.0 + nrm(ks[25], (L, D_RWKV), 0.01),
        'gn_b': nrm(ks[26], (L, D_RWKV), 0.01),
        'pool_w': nrm(ks[27], (L, N_POOL_GROUPS, POOL_GROUP, POOL_GROUP), POOL_GROUP ** -0.5),
        'pool_scale': 1.0 + nrm(ks[28], (L, D_POOL), 0.1),
        'fourier_w': nrm(ks[29], (L, D_FOUR, D_FOUR), D_FOUR ** -0.5),
        'w_out': nrm(ks[30], (L, D_MIX, D_MODEL), DEEPNORM_BETA * D_MIX ** -0.5),
    }


def reference(x, c, ctx, c_ctx, w_mod, b_mod, ln_g, ln_b, w_ffn_in, w_ffn_out, w_in, q_norm_g, k_norm_g,
              rwkv_mu, decay_w0, decay_w1, decay_w2, icl_a0, icl_a1, icl_a2, gate_g1, gate_g2, k_k, k_a, r_k,
              gn_g, gn_b, pool_w, pool_scale, fourier_w, w_out):
    B = x.shape[0]
    xl = x
    xc = ctx
    sc = jax.nn.silu(c)
    scc = jax.nn.silu(c_ctx)
    for l in range(DEPTH):
        last = l == DEPTH - 1
        p = {
            'w_in': w_in[l], 'w_out': w_out[l], 'q_norm_g': q_norm_g[l], 'k_norm_g': k_norm_g[l],
            'rwkv_mu': rwkv_mu[l], 'decay_w0': decay_w0[l], 'decay_w1': decay_w1[l], 'decay_w2': decay_w2[l],
            'icl_a0': icl_a0[l], 'icl_a1': icl_a1[l], 'icl_a2': icl_a2[l], 'gate_g1': gate_g1[l],
            'gate_g2': gate_g2[l], 'k_k': k_k[l], 'k_a': k_a[l], 'r_k': r_k[l], 'gn_g': gn_g[l], 'gn_b': gn_b[l],
            'pool_w': pool_w[l], 'pool_scale': pool_scale[l], 'fourier_w': fourier_w[l],
        }
        ml = (sc @ w_mod[l] + b_mod[l]).reshape(B, N_SUB, 3, 1, D_MODEL)
        mc = (scc @ w_mod[l] + b_mod[l]).reshape(N_SUB, 3, 1, 1, D_MODEL)
        xl = post_norm(xl, swiglu(modulate(xl, ml[:, 0, 0], ml[:, 0, 1]), w_ffn_in[l, 0], w_ffn_out[l, 0]),
                       ml[:, 0, 2], ln_g[l, 0], ln_b[l, 0], 0.5)
        xc = post_norm(xc, swiglu(modulate(xc, mc[0, 0], mc[0, 1]), w_ffn_in[l, 0], w_ffn_out[l, 0]),
                       mc[0, 2], ln_g[l, 0], ln_b[l, 0], 0.5)
        yl, yc = mixer(modulate(xl, ml[:, 1, 0], ml[:, 1, 1]), modulate(xc, mc[1, 0], mc[1, 1]), p, not last)
        xl = post_norm(xl, yl, ml[:, 1, 2], ln_g[l, 1], ln_b[l, 1], 1.0)
        xl = post_norm(xl, swiglu(modulate(xl, ml[:, 2, 0], ml[:, 2, 1]), w_ffn_in[l, 1], w_ffn_out[l, 1]),
                       ml[:, 2, 2], ln_g[l, 2], ln_b[l, 2], 0.5)
        if not last:
            xc = post_norm(xc, yc, mc[1, 2], ln_g[l, 1], ln_b[l, 1], 1.0)
            xc = post_norm(xc, swiglu(modulate(xc, mc[2, 0], mc[2, 1]), w_ffn_in[l, 1], w_ffn_out[l, 1]),
                           mc[2, 2], ln_g[l, 2], ln_b[l, 2], 0.5)
    return xl
```

```cpp
#include <hip/hip_runtime.h>
#include <hip/hip_cooperative_groups.h>
#include <cstdio>
#include <cstdint>
namespace cg = cooperative_groups;

__device__ __forceinline__ int tid_opq() { int t = threadIdx.x; asm volatile("" : "+v"(t)); return t; }
__device__ __forceinline__ int bx_opq() { int t = blockIdx.x; asm volatile("" : "+s"(t)); return t; }
namespace pg8 {
#define PG8_LAS __attribute__((address_space(3)))
typedef unsigned short bf16_t;
typedef short bf16x8 __attribute__((ext_vector_type(8)));
typedef float f32x4 __attribute__((ext_vector_type(4)));
typedef unsigned u32x4 __attribute__((ext_vector_type(4)));
constexpr int BM = 256, BK = 64, HALF = 128, HTB = HALF * BK * 2, STAGE_BYTES = 8 * HTB, NXCD = 8, WGM = 8;

__host__ __device__ __forceinline__ int lds_byte(int r, int c) { const int st = (r >> 4) * 2 + (c >> 5), rr = r & 15, cc = c & 31, ob = rr * 64 + cc * 2; return st * 1024 + (ob ^ (((ob >> 9) & 1) << 5)); }
__host__ __device__ __forceinline__ void stage_rc(int b, int& R, int& C) { const int st = b / 1024, sb = b % 1024, swz = sb ^ (((sb >> 9) & 1) << 5); R = (st >> 1) * 16 + swz / 64; C = (st & 1) * 32 + (swz % 64) / 2; }
__host__ __device__ __forceinline__ int perm32(int rho) { const int n = rho >> 4, i = rho & 15; return 8 * (i >> 2) + 4 * n + (i & 3); }

struct Unit { int pm, pn, ks; };
struct Gemm { const bf16_t* A; const bf16_t* Bt; int lda, ldb, K; };

struct StaticOrder {
    int nM, nN, nNS, nwg, G, c;
    __device__ void init(int M, int N, int nS, int G_, int c_) { nM = M / BM; nN = N / BM; nNS = nN * nS; nwg = nM * nNS; G = G_; c = c_; }
    __device__ bool next(int i, Unit& u) const {
        const long L = (long)i * G + c; if (L >= nwg) return false;
        int wgid = (int)L; { const int q = nwg / NXCD, r = nwg % NXCD, xcd = wgid % NXCD, off = wgid / NXCD; wgid = (xcd < r ? xcd * (q + 1) : r * (q + 1) + (xcd - r) * q) + off; }
        const int nig = WGM * nNS, gid = wgid / nig, fm = gid * WGM, gsz = (nM - fm) < WGM ? (nM - fm) : WGM;
        u.pm = fm + ((wgid % nig) % gsz); const int pc = (wgid % nig) / gsz; u.pn = pc % nN; u.ks = pc / nN; return true;
    }
    __device__ __forceinline__ void a_ready(const Unit&) const {}
    __device__ __forceinline__ void done(const Unit&) const {}
};

__device__ __forceinline__ unsigned cvt_pk_bf16(float lo, float hi) { unsigned r; asm volatile("v_cvt_pk_bf16_f32 %0, %1, %2" : "=v"(r) : "v"(lo), "v"(hi)); return r; }
__device__ __forceinline__ float silu_f(float x) { return x * __builtin_amdgcn_rcpf(1.0f + __builtin_amdgcn_exp2f(-1.4426950408889634f * x)); }

struct EpiSwiglu {
    static constexpr bool PERM = true, AFTER_DRAIN = false;
    bf16_t* O; int ldc;
    __device__ __forceinline__ void operator()(const f32x4 (&acc)[2][2][4][2], const Unit& u, int wr, int wc, int fr, int fq) const {
        const int row0 = u.pm * BM + wr * 64 + fr, col0 = u.pn * HALF + wc * 32 + 8 * fq;
#pragma unroll
        for (int ai = 0; ai < 2; ++ai)
#pragma unroll
            for (int m = 0; m < 4; ++m) {
                bf16_t* rowp = O + (size_t)(row0 + ai * HALF + m * 16) * ldc + col0;
                const f32x4 g0 = acc[ai][0][m][0], g1 = acc[ai][0][m][1], u0 = acc[ai][1][m][0], u1 = acc[ai][1][m][1];
                u32x4 w;
                w.x = cvt_pk_bf16(silu_f(g0[0]) * u0[0], silu_f(g0[1]) * u0[1]); w.y = cvt_pk_bf16(silu_f(g0[2]) * u0[2], silu_f(g0[3]) * u0[3]);
                w.z = cvt_pk_bf16(silu_f(g1[0]) * u1[0], silu_f(g1[1]) * u1[1]); w.w = cvt_pk_bf16(silu_f(g1[2]) * u1[2], silu_f(g1[3]) * u1[3]);
                *(u32x4*)rowp = w;
            }
    }
};
struct EpiF32 {
    static constexpr bool PERM = false, AFTER_DRAIN = false;
    float* O; int ldc; size_t sstride;
    __device__ __forceinline__ void operator()(const f32x4 (&acc)[2][2][4][2], const Unit& u, int wr, int wc, int fr, int fq) const {
        const int row0 = u.pm * BM + wr * 64 + fr, col0 = u.pn * BM + wc * 32 + 4 * fq;
        float* base = O + (size_t)u.ks * sstride;
#pragma unroll
        for (int ai = 0; ai < 2; ++ai)
#pragma unroll
            for (int m = 0; m < 4; ++m) {
                float* rowp = base + (size_t)(row0 + ai * HALF + m * 16) * ldc + col0;
#pragma unroll
                for (int bj = 0; bj < 2; ++bj)
#pragma unroll
                    for (int n = 0; n < 2; ++n) *(f32x4*)(rowp + bj * HALF + n * 16) = acc[ai][bj][m][n];
            }
    }
};
struct EpiWin {
    static constexpr bool PERM = true, AFTER_DRAIN = false;
    bf16_t* Z; bf16_t* ZT; bf16_t* ZTC;
    __device__ __forceinline__ void operator()(const f32x4 (&acc)[2][2][4][2], const Unit& u, int wr, int wc, int fr, int fq) const {
        const int row0 = u.pm * BM + wr * 64 + fr;
        if (u.pn < 7) {
            const int col0 = u.pn * BM + wc * 32 + 8 * fq;
#pragma unroll
            for (int ai = 0; ai < 2; ++ai)
#pragma unroll
                for (int m = 0; m < 4; ++m) {
                    bf16_t* rowp = Z + (size_t)(row0 + ai * HALF + m * 16) * 1792 + col0;
#pragma unroll
                    for (int bj = 0; bj < 2; ++bj) { const f32x4 v0 = acc[ai][bj][m][0], v1 = acc[ai][bj][m][1]; u32x4 w;
                        w.x = cvt_pk_bf16(v0[0], v0[1]); w.y = cvt_pk_bf16(v0[2], v0[3]); w.z = cvt_pk_bf16(v1[0], v1[1]); w.w = cvt_pk_bf16(v1[2], v1[3]);
                        *(u32x4*)(rowp + bj * HALF) = w; }
                }
        } else {
            const int part = u.pn - 7;
#pragma unroll
            for (int ai = 0; ai < 2; ++ai)
#pragma unroll
                for (int m = 0; m < 4; ++m) {
                    const int row = row0 + ai * HALF + m * 16;
                    bf16_t* base; size_t ld;
                    if (row < 16384) { const int b = row >> 12, t = row & 4095; base = ZT + (size_t)(b * 256) * 8192 + part * 4096 + t; ld = 8192; }
                    else { const int rr = row - 16384, b = rr >> 8, j = rr & 255; base = ZTC + (size_t)(b * 256) * 512 + part * 256 + j; ld = 512; }
#pragma unroll
                    for (int bj = 0; bj < 2; ++bj)
#pragma unroll
                        for (int n = 0; n < 2; ++n) { const f32x4 v = acc[ai][bj][m][n]; const int ch = bj * HALF + wc * 32 + 8 * fq + 4 * n;
                            const unsigned p0 = cvt_pk_bf16(v[0], v[1]), p1 = cvt_pk_bf16(v[2], v[3]);
                            base[(size_t)(ch + 0) * ld] = (bf16_t)(p0 & 0xffffu); base[(size_t)(ch + 1) * ld] = (bf16_t)(p0 >> 16);
                            base[(size_t)(ch + 2) * ld] = (bf16_t)(p1 & 0xffffu); base[(size_t)(ch + 3) * ld] = (bf16_t)(p1 >> 16); }
                }
        }
    }
};

template <class Epi, class Sched, bool ALIGN_EPI = false, bool SP2 = false>
__device__ __forceinline__ void gemm_phase(PG8_LAS unsigned char* lds, const Gemm g, const Sched& S, const Epi& E) {
    const int tid = tid_opq(), wid = __builtin_amdgcn_readfirstlane(tid >> 6), lane = tid & 63, wr = wid >> 2, wc = wid & 3, fr = lane & 15, fq = lane >> 4;
    const int K = g.K, nt = K / BK;
    unsigned voffA[2], voffB[2];
#pragma unroll
    for (int i = 0; i < 2; ++i) { int R, C; stage_rc(tid * 16 + i * 8192, R, C); const int Rb = Epi::PERM ? ((R & ~31) + perm32(R & 31)) : R;
        voffA[i] = (unsigned)(R * g.lda + C) * 2u; voffB[i] = (unsigned)(Rb * g.ldb + C) * 2u; }
    const size_t kstep = (size_t)(BK * 2);
    const size_t hstepA = (size_t)HALF * g.lda * 2, hstepB = (size_t)HALF * g.ldb * 2;
    const size_t tstepA = 2 * hstepA, tstepB = 2 * hstepB, ksb = (size_t)K * 2;
    const unsigned ldsw = (unsigned)wid * 1024u;
    const int aoff = lds_byte(wr * 64 + fr, fq * 8), boff = lds_byte(wc * 32 + fr, fq * 8);
#define PG8_SA(b, h) (((b) * 2 + (h)) * HTB)
#define PG8_SB(b, h) ((4 + (b) * 2 + (h)) * HTB)
#define PG8_STAGE(bufoff, gbase, voff) do { _Pragma("unroll") for (int _i = 0; _i < 2; ++_i) \
        __builtin_amdgcn_global_load_lds((const unsigned*)((const char*)(gbase) + (voff)[_i]), (PG8_LAS unsigned*)(lds + (bufoff) + ldsw + _i * 8192), 16, 0, 0); } while (0)
#define PG8_LDA(dst, b, h) do { _Pragma("unroll") for (int m = 0; m < 4; ++m) _Pragma("unroll") for (int k = 0; k < 2; ++k) dst[m][k] = *(const PG8_LAS bf16x8*)(lds + PG8_SA(b, h) + aoff + m * 2048 + k * 1024); } while (0)
#define PG8_LDB(dst, b, h) do { _Pragma("unroll") for (int n = 0; n < 2; ++n) _Pragma("unroll") for (int k = 0; k < 2; ++k) dst[n][k] = *(const PG8_LAS bf16x8*)(lds + PG8_SB(b, h) + boff + n * 2048 + k * 1024); } while (0)
#define PG8_MMA(ai, bj, At, Bt) do { __builtin_amdgcn_s_setprio(1); _Pragma("unroll") for (int m = 0; m < 4; ++m) _Pragma("unroll") for (int n = 0; n < 2; ++n) _Pragma("unroll") for (int k = 0; k < 2; ++k) \
        acc[ai][bj][m][n] = __builtin_amdgcn_mfma_f32_16x16x32_bf16(Bt[n][k], At[m][k], acc[ai][bj][m][n], 0, 0, 0); __builtin_amdgcn_s_setprio(0); } while (0)
#define PG8_WAIT_V(n) asm volatile("s_waitcnt vmcnt(" #n ")" ::: "memory")
#define PG8_WAIT_L(n) asm volatile("s_waitcnt lgkmcnt(" #n ")" ::: "memory")
#define PG8_BAR __builtin_amdgcn_s_barrier()
#define PG8_SCHED __builtin_amdgcn_sched_barrier(0)
    Unit cur, nxt; int ui = 0;
    if (!S.next(0, cur)) return;
    f32x4 acc[2][2][4][2];
#pragma unroll
    for (int a = 0; a < 2; ++a)
#pragma unroll
        for (int b = 0; b < 2; ++b)
#pragma unroll
            for (int m = 0; m < 4; ++m)
#pragma unroll
                for (int n = 0; n < 2; ++n) acc[a][b][m][n] = (f32x4){0.f, 0.f, 0.f, 0.f};
    bf16x8 At[4][2], B0[2][2], B1[2][2];
    const char* cA = (const char*)g.A + (size_t)cur.pm * tstepA + (size_t)cur.ks * ksb; const char* cB = (const char*)g.Bt + (size_t)cur.pn * tstepB + (size_t)cur.ks * ksb;
    S.a_ready(cur);
    if constexpr (SP2) {
        PG8_STAGE(PG8_SB(0, 0), cB, voffB); PG8_STAGE(PG8_SB(0, 1), cB + hstepB, voffB); PG8_STAGE(PG8_SA(0, 0), cA, voffA); PG8_STAGE(PG8_SA(0, 1), cA + hstepA, voffA);
        if (wr == 1) PG8_BAR;
        PG8_WAIT_V(2); PG8_BAR;
        PG8_STAGE(PG8_SB(1, 0), cB + kstep, voffB); PG8_STAGE(PG8_SA(1, 0), cA + kstep, voffA); PG8_STAGE(PG8_SB(1, 1), cB + hstepB + kstep, voffB);
        PG8_WAIT_V(6); PG8_BAR;
    } else {
        PG8_STAGE(PG8_SB(0, 0), cB, voffB); PG8_STAGE(PG8_SA(0, 0), cA, voffA); PG8_STAGE(PG8_SB(0, 1), cB + hstepB, voffB); PG8_STAGE(PG8_SA(0, 1), cA + hstepA, voffA);
        if (wr == 1) PG8_BAR;
        PG8_WAIT_V(4); PG8_BAR;
        PG8_STAGE(PG8_SB(1, 0), cB + kstep, voffB); PG8_STAGE(PG8_SA(1, 0), cA + kstep, voffA); PG8_STAGE(PG8_SB(1, 1), cB + hstepB + kstep, voffB);
        PG8_WAIT_V(6); PG8_BAR;
    }
    for (;;) {
        const bool has_next = S.next(ui + 1, nxt);
        const char* nA = has_next ? (const char*)g.A + (size_t)nxt.pm * tstepA + (size_t)nxt.ks * ksb : cA; const char* nB = has_next ? (const char*)g.Bt + (size_t)nxt.pn * tstepB + (size_t)nxt.ks * ksb : cB;
        for (int t = 0; t < nt; t += 2) {
            const bool last = (t == nt - 2);
            const char* a1 = cA + (size_t)(t + 1) * kstep;
            const char* a2 = last ? nA : cA + (size_t)(t + 2) * kstep; const char* b2 = last ? nB : cB + (size_t)(t + 2) * kstep;
            const char* a3 = a2 + kstep; const char* b3 = b2 + kstep;
            if (last && has_next) S.a_ready(nxt);
            if constexpr (SP2) {
            PG8_LDB(B0, 0, 0); PG8_LDB(B1, 0, 1); PG8_SCHED; PG8_LDA(At, 0, 0); PG8_STAGE(PG8_SA(1, 1), a1 + hstepA, voffA);
            PG8_WAIT_V(8); PG8_WAIT_L(0); PG8_BAR; PG8_MMA(0, 0, At, B0); PG8_MMA(0, 1, At, B1); PG8_BAR; PG8_SCHED;
            PG8_LDA(At, 0, 1); PG8_STAGE(PG8_SB(0, 0), b2, voffB); PG8_STAGE(PG8_SB(0, 1), b2 + hstepB, voffB); PG8_STAGE(PG8_SA(0, 0), a2, voffA);
            PG8_WAIT_V(8); PG8_WAIT_L(0); PG8_BAR; PG8_MMA(1, 0, At, B0); PG8_MMA(1, 1, At, B1); PG8_BAR; PG8_SCHED;
            PG8_LDB(B0, 1, 0); PG8_LDB(B1, 1, 1); PG8_SCHED; PG8_LDA(At, 1, 0); PG8_STAGE(PG8_SA(0, 1), a2 + hstepA, voffA);
            PG8_WAIT_V(8); PG8_WAIT_L(0); PG8_BAR; PG8_MMA(0, 0, At, B0); PG8_MMA(0, 1, At, B1); PG8_BAR; PG8_SCHED;
            PG8_LDA(At, 1, 1); PG8_STAGE(PG8_SB(1, 0), b3, voffB); PG8_STAGE(PG8_SB(1, 1), b3 + hstepB, voffB); PG8_STAGE(PG8_SA(1, 0), a3, voffA);
            PG8_WAIT_V(8); PG8_WAIT_L(0); PG8_BAR; PG8_MMA(1, 0, At, B0); PG8_MMA(1, 1, At, B1); PG8_BAR; PG8_SCHED;
            } else {
            PG8_LDB(B0, 0, 0); PG8_SCHED; PG8_LDA(At, 0, 0); PG8_STAGE(PG8_SA(1, 1), a1 + hstepA, voffA);
            PG8_WAIT_L(8); PG8_BAR; PG8_WAIT_L(0); PG8_MMA(0, 0, At, B0); PG8_BAR; PG8_SCHED;
            PG8_LDB(B1, 0, 1); PG8_STAGE(PG8_SB(0, 0), b2, voffB);
            PG8_BAR; PG8_WAIT_L(0); PG8_MMA(0, 1, At, B1); PG8_BAR;
            PG8_LDA(At, 0, 1); PG8_STAGE(PG8_SA(0, 0), a2, voffA);
            PG8_BAR; PG8_WAIT_L(0); PG8_MMA(1, 0, At, B0); PG8_BAR; PG8_SCHED;
            PG8_STAGE(PG8_SB(0, 1), b2 + hstepB, voffB);
            PG8_WAIT_V(6); PG8_BAR; PG8_MMA(1, 1, At, B1); PG8_BAR;
            PG8_LDB(B0, 1, 0); PG8_SCHED; PG8_LDA(At, 1, 0); PG8_STAGE(PG8_SA(0, 1), a2 + hstepA, voffA);
            PG8_WAIT_L(8); PG8_BAR; PG8_WAIT_L(0); PG8_MMA(0, 0, At, B0); PG8_BAR; PG8_SCHED;
            PG8_LDB(B1, 1, 1); PG8_STAGE(PG8_SB(1, 0), b3, voffB);
            PG8_BAR; PG8_WAIT_L(0); PG8_MMA(0, 1, At, B1); PG8_BAR;
            PG8_LDA(At, 1, 1); PG8_STAGE(PG8_SA(1, 0), a3, voffA);
            PG8_BAR; PG8_WAIT_L(0); PG8_MMA(1, 0, At, B0); PG8_BAR; PG8_SCHED;
            PG8_STAGE(PG8_SB(1, 1), b3 + hstepB, voffB);
            PG8_WAIT_V(6); PG8_BAR; PG8_MMA(1, 1, At, B1); PG8_BAR;
            }
        }
        if constexpr (ALIGN_EPI) { if (wr == 0) PG8_BAR; }
        if constexpr (!Epi::AFTER_DRAIN) { E(acc, cur, wr, wc, fr, fq); S.done(cur); }
        if (!has_next) break;
#pragma unroll
        for (int a = 0; a < 2; ++a)
#pragma unroll
            for (int b = 0; b < 2; ++b)
#pragma unroll
                for (int m = 0; m < 4; ++m)
#pragma unroll
                    for (int n = 0; n < 2; ++n) acc[a][b][m][n] = (f32x4){0.f, 0.f, 0.f, 0.f};
        cur = nxt; cA = nA; cB = nB; ++ui;
        if constexpr (ALIGN_EPI) { if (wr == 1) PG8_BAR; }
    }
    PG8_WAIT_V(0);
    if constexpr (!ALIGN_EPI) { if (wr == 0) PG8_BAR; }
    PG8_BAR;
    if constexpr (Epi::AFTER_DRAIN) { E.fused(acc, cur, wr, wc, fr, fq, lds, wid, lane); S.done(cur); }
#undef PG8_SA
#undef PG8_SB
#undef PG8_STAGE
#undef PG8_LDA
#undef PG8_LDB
#undef PG8_MMA
#undef PG8_WAIT_V
#undef PG8_WAIT_L
#undef PG8_BAR
#undef PG8_SCHED
}
}

using pg8::bf16_t;
using pg8::cvt_pk_bf16;
typedef float f4v __attribute__((ext_vector_type(4)));
typedef short s16x8 __attribute__((ext_vector_type(8)));
typedef short s16x4 __attribute__((ext_vector_type(4)));
typedef unsigned u32x4v __attribute__((ext_vector_type(4)));
typedef unsigned u32x2v __attribute__((ext_vector_type(2)));
#define LAS __attribute__((address_space(3)))

constexpr int DM = 1024, NBAT = 4, SEQ = 4096, DEPTH = 4, CTXL = 256, DFF = 2816;
constexpr int ML = NBAT * SEQ, MC = NBAT * CTXL, MT = ML + MC;
constexpr int NIN = 2304, ZW = 1792, TK = SEQ + CTXL;
constexpr int NCH = 32, CHL = TK / NCH;
constexpr float ALPHA = 1.681792830507429f;
constexpr float QSCALE = 0.125f * 1.4426950408889634f;

constexpr size_t MiB = 1u << 20;
constexpr size_t OFF_CTL = 0, OFF_MOD = 1 * MiB, OFF_WGU = 2 * MiB, OFF_WDN = 90 * MiB, OFF_WIN = 134 * MiB, OFF_WOUT = 152 * MiB,
                 OFF_DFT = 160 * MiB, OFF_DFTC = 224 * MiB, OFF_X = 225 * MiB, OFF_H = 293 * MiB, OFF_Y = 327 * MiB, OFF_HID = 395 * MiB,
                 OFF_Z = 395 * MiB, OFF_ZT = 455 * MiB, OFF_ZTC = 471 * MiB, OFF_Q = 472 * MiB, OFF_QC = 480 * MiB, OFF_K = 481 * MiB, OFF_VT = 486 * MiB,
                 OFF_RW = 491 * MiB, OFF_BON = 644 * MiB, OFF_G = 653 * MiB, OFF_PST = 662 * MiB, OFF_UST = 678 * MiB, WS_END = 694 * MiB;
constexpr size_t OFF_CONCAT = OFF_H, OFF_PART = OFF_Y, OFF_PARTC = OFF_Y + 64 * MiB, OFF_YS = OFF_Z, OFF_SST = OFF_ZT;
static_assert((size_t)32 * NCH * 4096 * 4 <= 16 * MiB, "chunk-state buffers are 16 MiB each");
constexpr size_t RWA = (size_t)MT * 256;
enum { RW_R = 0, RW_V, RW_KK, RW_W0, RW_W1, RW_KD0, RW_KD1, RW_B0, RW_B1 };
constexpr int LDS_BYTES = 147456;

struct Args { const float* in[31]; float* out; unsigned char* ws; int ph_lo, ph_hi; };
typedef const Args __attribute__((address_space(4))) CArgs;
__device__ __forceinline__ CArgs* kargs() { unsigned long long v = (unsigned long long)__builtin_amdgcn_kernarg_segment_ptr(); asm volatile("" : "+s"(v)); return (CArgs*)v; }
#define KA (*kargs())
enum { I_X = 0, I_C, I_CTX, I_CCTX, I_WMOD, I_BMOD, I_LNG, I_LNB, I_WFI, I_WFO, I_WIN, I_QG, I_KG, I_MU, I_DW0, I_DW1, I_DW2, I_IA0, I_IA1, I_IA2, I_GG1, I_GG2,
       I_KK, I_KA, I_RK, I_GNG, I_GNB, I_PW, I_PS, I_FW, I_WOUT };

__device__ __forceinline__ float bf2f(bf16_t u) { return __uint_as_float((unsigned)u << 16); }
__device__ __forceinline__ bf16_t f2bf(float f) { const unsigned u = __float_as_uint(f); return (bf16_t)((u + 0x7fffu + ((u >> 16) & 1u)) >> 16); }
__device__ __forceinline__ float wsum(float v) {
#pragma unroll
    for (int o = 32; o; o >>= 1) v += __shfl_xor(v, o);
    return v;
}
__device__ __forceinline__ float sigm(float x) { return 1.0f / (1.0f + __expf(-x)); }

__device__ __forceinline__ void tcvt_tile(const float* __restrict__ src, int src_ld, int k0, int c0, bf16_t* __restrict__ dst, int dst_ld, int n0, float* tile) {
    const int tid = tid_opq();
#pragma unroll
    for (int i = 0; i < 8; ++i) { const int k = i * 8 + (tid >> 6), n = tid & 63; tile[k * 65 + n] = src[(size_t)(k0 + k) * src_ld + c0 + n]; }
    __syncthreads();
#pragma unroll
    for (int i = 0; i < 4; ++i) { const int n = i * 16 + (tid >> 5), k = (tid & 31) * 2;
        *(unsigned*)(dst + (size_t)(n0 + n) * dst_ld + k0 + k) = cvt_pk_bf16(tile[k * 65 + n], tile[(k + 1) * 65 + n]); }
    __syncthreads();
}

__device__ void prologue_a(CArgs& a, float* sm) {
    unsigned char* ws = a.ws;
    const int tid = tid_opq(), G = gridDim.x, bx = bx_opq();
    bf16_t* WGU = (bf16_t*)(ws + OFF_WGU); bf16_t* WDN = (bf16_t*)(ws + OFF_WDN); bf16_t* WIN = (bf16_t*)(ws + OFF_WIN); bf16_t* WOUT = (bf16_t*)(ws + OFF_WOUT);
    if (bx == 0 && tid < 64) ((unsigned*)(ws + OFF_CTL))[tid] = 0u;
    float* tile = sm;
    for (int j = bx; j < 19200; j += G) {
        if (j < 11264) { const int mat = j / 1408, r = j % 1408, kt = r / 88, nt = r % 88, n0 = nt * 64, pn = n0 >> 8, bj = (n0 >> 7) & 1, i0 = n0 & 127;
            tcvt_tile(a.in[I_WFI] + (size_t)mat * 1024 * 5632, 5632, kt * 64, bj * 2816 + pn * 128 + i0, WGU + (size_t)mat * 5632 * 1024, 1024, n0, tile); }
        else if (j < 16896) { const int jj = j - 11264, mat = jj / 704, r = jj % 704, kt = r / 16, nt = r % 16;
            tcvt_tile(a.in[I_WFO] + (size_t)mat * 2816 * 1024, 1024, kt * 64, nt * 64, WDN + (size_t)mat * 1024 * 2816, 2816, nt * 64, tile); }
        else if (j < 18688) { const int jj = j - 16896, l = jj / 448, r = jj % 448, kt = r / 28, nt = r % 28;
            tcvt_tile(a.in[I_WIN] + (size_t)l * 1024 * 2048, 2048, kt * 64, nt * 64, WIN + (size_t)l * NIN * 1024, 1024, nt * 64, tile); }
        else { const int jj = j - 18688, l = jj / 128, r = jj % 128, kt = r / 16, nt = r % 16;
            tcvt_tile(a.in[I_WOUT] + (size_t)l * 1024 * 1024, 1024, kt * 64, nt * 64, WOUT + (size_t)l * 1024 * 1024, 1024, nt * 64, tile); }
    }
    float* tab = sm;
    float* sc = sm + 4096;
    for (int m = tid; m < 4096; m += 512) tab[m] = cospif((float)m * (1.0f / 2048.0f));
    for (int i = tid; i < 5 * 1024; i += 512) { const float v = i < 4096 ? a.in[I_C][i] : a.in[I_CCTX][i - 4096]; sc[i] = v * sigm(v); }
    __syncthreads();
    const size_t gt = (size_t)bx * 512 + tid, gn = (size_t)G * 512;
    for (size_t idx = gt; idx < (size_t)4 * 1024 * 512; idx += gn) {
        const int kc = idx & 63, g = (idx >> 6) & 3, part = (idx >> 8) & 1, k = (idx >> 9) & 1023, l = (int)(idx >> 19);
        const float* src = a.in[I_WIN] + ((size_t)l * 1024 + k) * 2048 + 1792 + 64 * g;
        float acc = 0.f;
        for (int c = 0; c < 64; ++c) { const int m = ((c * kc) & 63) * 64; const float tr = part ? -tab[(m - 1024) & 4095] : tab[m]; acc += src[c] * tr; }
        WIN[((size_t)l * NIN + 1792 + part * 256 + g * 64 + kc) * 1024 + k] = f2bf(acc);
    }
    for (size_t idx = gt; idx < (size_t)4 * 4 * 8 * 1024; idx += gn) {
        const int n = idx & 1023, c8 = (idx >> 10) & 7, g = (idx >> 13) & 3, l = (int)(idx >> 15);
        const float* pw = a.in[I_PW] + (((size_t)l * 4 + g) * 64 + c8 * 8) * 64;
        const float* ps = a.in[I_PS] + l * 256 + 64 * g;
        const float* wo = a.in[I_WOUT] + ((size_t)l * 1024 + 512 + 64 * g) * 1024 + n;
        float acc[8];
#pragma unroll
        for (int e = 0; e < 8; ++e) acc[e] = 0.f;
        for (int d = 0; d < 64; ++d) { const float w = wo[(size_t)d * 1024] * ps[d];
#pragma unroll
            for (int e = 0; e < 8; ++e) acc[e] += pw[e * 64 + d] * w; }
        bf16_t* dst = WOUT + ((size_t)l * 1024 + n) * 1024 + 512 + 64 * g + c8 * 8;
        u32x4v o; o.x = cvt_pk_bf16(acc[0], acc[1]); o.y = cvt_pk_bf16(acc[2], acc[3]); o.z = cvt_pk_bf16(acc[4], acc[5]); o.w = cvt_pk_bf16(acc[6], acc[7]);
        *(u32x4v*)dst = o;
    }
    for (size_t idx = gt; idx < (size_t)4 * 32 * 1024; idx += gn) {
        const int n = idx & 1023, i8 = (idx >> 10) & 31, l = (int)(idx >> 15);
        const float* fw = a.in[I_FW] + ((size_t)l * 256 + i8 * 8) * 256;
        const float* wo = a.in[I_WOUT] + ((size_t)l * 1024 + 768) * 1024 + n;
        float acc[8];
#pragma unroll
        for (int e = 0; e < 8; ++e) acc[e] = 0.f;
        for (int j = 0; j < 256; ++j) { const float w = wo[(size_t)j * 1024];
#pragma unroll
            for (int e = 0; e < 8; ++e) acc[e] += fw[e * 256 + j] * w; }
        bf16_t* dst = WOUT + ((size_t)l * 1024 + n) * 1024 + 768 + i8 * 8;
        u32x4v o; o.x = cvt_pk_bf16(acc[0], acc[1]); o.y = cvt_pk_bf16(acc[2], acc[3]); o.z = cvt_pk_bf16(acc[4], acc[5]); o.w = cvt_pk_bf16(acc[6], acc[7]);
        *(u32x4v*)dst = o;
    }
    {
        bf16_t* DFT = (bf16_t*)(ws + OFF_DFT); bf16_t* DFTC = (bf16_t*)(ws + OFF_DFTC);
        for (size_t idx = gt; idx < (size_t)4096 * 1024; idx += gn) {
            const int kt = (int)(idx >> 10), c8 = (int)(idx & 1023), part = c8 >> 9, t0 = (c8 & 511) * 8;
            float v[8];
#pragma unroll
            for (int e = 0; e < 8; ++e) { const int m = (kt * (t0 + e)) & 4095; v[e] = tab[part ? ((m - 1024) & 4095) : m] * (1.0f / 512.0f); }
            u32x4v o; o.x = cvt_pk_bf16(v[0], v[1]); o.y = cvt_pk_bf16(v[2], v[3]); o.z = cvt_pk_bf16(v[4], v[5]); o.w = cvt_pk_bf16(v[6], v[7]);
            *(u32x4v*)(DFT + (size_t)kt * 8192 + c8 * 8) = o;
        }
        for (size_t idx = gt; idx < (size_t)256 * 64; idx += gn) {
            const int kt = (int)(idx >> 6), c8 = (int)(idx & 63), part = c8 >> 5, t0 = (c8 & 31) * 8;
            float v[8];
#pragma unroll
            for (int e = 0; e < 8; ++e) { const int m = ((kt * (t0 + e)) & 255) * 16; v[e] = tab[part ? ((m - 1024) & 4095) : m] * (1.0f / 128.0f); }
            u32x4v o; o.x = cvt_pk_bf16(v[0], v[1]); o.y = cvt_pk_bf16(v[2], v[3]); o.z = cvt_pk_bf16(v[4], v[5]); o.w = cvt_pk_bf16(v[6], v[7]);
            *(u32x4v*)(DFTC + (size_t)kt * 512 + c8 * 8) = o;
        }
    }
    {
        float* MOD = (float*)(ws + OFF_MOD);
        float* red = sm + 4096 + 5120;
        const int col = tid & 63, kg = tid >> 6;
        for (int it = bx; it < 4 * 144; it += G) {
            const int l = it / 144, n0 = (it % 144) * 64;
            const float* w = a.in[I_WMOD] + ((size_t)l * 1024 + kg * 128) * 9216 + n0 + col;
            float acc[5] = {0.f, 0.f, 0.f, 0.f, 0.f};
            for (int k = 0; k < 128; ++k) { const float wv = w[(size_t)k * 9216];
#pragma unroll
                for (int s = 0; s < 5; ++s) acc[s] += sc[s * 1024 + kg * 128 + k] * wv; }
#pragma unroll
            for (int s = 0; s < 5; ++s) red[(kg * 5 + s) * 64 + col] = acc[s];
            __syncthreads();
            if (tid < 320) { const int s = tid >> 6; float t = a.in[I_BMOD][l * 9216 + n0 + col];
#pragma unroll
                for (int q = 0; q < 8; ++q) t += red[(q * 5 + s) * 64 + col];
                MOD[((size_t)l * 5 + s) * 9216 + n0 + col] = t; }
            __syncthreads();
        }
    }
}

__device__ void rowwise_phase(CArgs& a, int mode, int l, int sub, float resid_w, int nl, int nsub, bool final_out) {
    unsigned char* ws = a.ws;
    const float* MOD = (const float*)(ws + OFF_MOD);
    float* X = (float*)(ws + OFF_X); const float* Y = (const float*)(ws + OFF_Y); bf16_t* H = (bf16_t*)(ws + OFF_H);
    const int lane = tid_opq() & 63, wid = tid_opq() >> 6;
    for (int row = bx_opq() * 8 + wid; row < MT; row += gridDim.x * 8) {
        const int s = row < ML ? (row >> 12) : 4;
        f4v v[4];
        if (mode == 0) {
            const float* src = row < ML ? a.in[I_X] + (size_t)row * DM : a.in[I_CTX] + (size_t)(row - ML) * DM;
#pragma unroll
            for (int q = 0; q < 4; ++q) v[q] = *(const f4v*)(src + q * 256 + lane * 4);
        } else {
            const float* gate = MOD + ((size_t)l * 5 + s) * 9216 + (sub * 3 + 2) * 1024;
            float sum = 0.f;
#pragma unroll
            for (int q = 0; q < 4; ++q) { const int col = q * 256 + lane * 4;
                const f4v x = *(const f4v*)(X + (size_t)row * DM + col), y = *(const f4v*)(Y + (size_t)row * DM + col), g = *(const f4v*)(gate + col);
                v[q] = ALPHA * x + resid_w * (g * y); sum += (v[q].x + v[q].y) + (v[q].z + v[q].w); }
            const float mean = wsum(sum) * (1.0f / 1024.0f);
            float sq = 0.f;
#pragma unroll
            for (int q = 0; q < 4; ++q) { const f4v d = v[q] - mean; sq += (d.x * d.x + d.y * d.y) + (d.z * d.z + d.w * d.w); }
            const float rstd = rsqrtf(wsum(sq) * (1.0f / 1024.0f) + 1e-5f);
            const float* lg = a.in[I_LNG] + ((size_t)l * 3 + sub) * 1024; const float* lb = a.in[I_LNB] + ((size_t)l * 3 + sub) * 1024;
#pragma unroll
            for (int q = 0; q < 4; ++q) { const int col = q * 256 + lane * 4; v[q] = (v[q] - mean) * rstd * *(const f4v*)(lg + col) + *(const f4v*)(lb + col); }
        }
        if (final_out) { if (row < ML) {
#pragma unroll
            for (int q = 0; q < 4; ++q) *(f4v*)(a.out + (size_t)row * DM + q * 256 + lane * 4) = v[q]; } }
        else {
#pragma unroll
            for (int q = 0; q < 4; ++q) *(f4v*)(X + (size_t)row * DM + q * 256 + lane * 4) = v[q]; }
        if (nl >= 0) {
            const float* sh = MOD + ((size_t)nl * 5 + s) * 9216 + (nsub * 3 + 0) * 1024; const float* scl = sh + 1024;
#pragma unroll
            for (int q = 0; q < 4; ++q) { const int col = q * 256 + lane * 4; const f4v h = v[q] * (1.0f + *(const f4v*)(scl + col)) + *(const f4v*)(sh + col);
                u32x2v o; o.x = cvt_pk_bf16(h.x, h.y); o.y = cvt_pk_bf16(h.z, h.w); *(u32x2v*)(H + (size_t)row * DM + col) = o; }
        }
    }
}

__device__ void attn_prep(CArgs& a, int l) {
    unsigned char* ws = a.ws;
    const bf16_t* Z = (const bf16_t*)(ws + OFF_Z);
    bf16_t* Q = (bf16_t*)(ws + OFF_Q); bf16_t* QC = (bf16_t*)(ws + OFF_QC); bf16_t* Kb = (bf16_t*)(ws + OFF_K); bf16_t* VT = (bf16_t*)(ws + OFF_VT);
    const int lane = tid_opq() & 63, slot = tid_opq() >> 6;
    const float gq = a.in[I_QG][l * 64 + lane], gk = a.in[I_KG][l * 64 + lane];
    const int ip = lane >> 1;
    const float inv = exp2f(-(float)(ip & 15) * (13.287712379549449f / 16.0f));
    for (int row = bx_opq(); row < MT; row += gridDim.x) {
        const bool lat = row < ML;
        const int b = lat ? (row >> 12) : ((row - ML) >> 8), t = lat ? (row & 4095) : ((row - ML) & 255), pos = lat ? 256 + t : t;
        const float z = bf2f(Z[(size_t)row * ZW + slot * 64 + lane]);
        if (slot < 6) {
            const float ss = wsum(z * z);
            float zn = z * rsqrtf(ss * (1.0f / 64.0f) + 1e-6f) * (slot < 4 ? gq : gk);
            if (lat) {
                const float ang = (float)(ip < 16 ? (t >> 6) : (t & 63)) * inv;
                float sn, cs; sincosf(ang, &sn, &cs);
                const float pr = __shfl_xor(zn, 1);
                zn = (lane & 1) ? (pr * sn + zn * cs) : (zn * cs - pr * sn);
            }
            if (slot < 4) { const bf16_t o = f2bf(zn * QSCALE);
                if (lat) Q[((size_t)(b * 4 + slot) * SEQ + t) * 64 + lane] = o; else QC[((size_t)(b * 4 + slot) * CTXL + t) * 64 + lane] = o; }
            else Kb[((size_t)(b * 2 + (slot - 4)) * TK + pos) * 64 + lane] = f2bf(zn);
        } else VT[((size_t)(b * 2 + (slot - 6)) * 64 + lane) * TK + pos] = f2bf(z);
    }
}

__device__ void pool_prep(CArgs& a) {
    unsigned char* ws = a.ws;
    const bf16_t* Z = (const bf16_t*)(ws + OFF_Z); bf16_t* CC = (bf16_t*)(ws + OFF_CONCAT);
    const int ch = tid_opq() & 255, g = ch >> 6, hw = 1 << g;
    for (int pr = bx_opq(); pr < MT / 2; pr += gridDim.x) {
        const int row = pr * 2 + (tid_opq() >> 8);
        const bool lat = row < ML;
        const int base = lat ? (row & ~4095) : (ML + ((row - ML) & ~255)), T = lat ? SEQ : CTXL, t = row - base;
        const int lo = t - hw < 0 ? 0 : t - hw, hi = t + hw > T ? T : t + hw;
        float sum = 0.f;
        for (int tt = lo; tt < hi; ++tt) sum += bf2f(Z[(size_t)(base + tt) * ZW + 1536 + ch]);
        const float zc = bf2f(Z[(size_t)row * ZW + 1536 + ch]);
        CC[(size_t)row * DM + 512 + ch] = f2bf(sum / (float)(hi - lo) - zc);
    }
}

__device__ void rwkv_prep(CArgs& a, int l, float* sm) {
    unsigned char* ws = a.ws;
    const bf16_t* Z = (const bf16_t*)(ws + OFF_Z);
    float* RW = (float*)(ws + OFF_RW); bf16_t* BON = (bf16_t*)(ws + OFF_BON); bf16_t* GG = (bf16_t*)(ws + OFF_G);
    float* Xs = sm;
    float* Ps = sm + 3 * 16 * 256;
    const int tid = tid_opq(), c = tid & 255, th = tid >> 8, h = c >> 6;
    const float* mu = a.in[I_MU] + (size_t)l * 6 * 256;
    const float mu0 = mu[c], mu1 = mu[256 + c], mu2 = mu[512 + c], mu3 = mu[768 + c], mu4 = mu[1024 + c], mu5 = mu[1280 + c];
    const float kkc = a.in[I_KK][l * 256 + c], kac = a.in[I_KA][l * 256 + c], rkc = a.in[I_RK][l * 256 + c];
    const float w00 = a.in[I_DW0][(l * 2 + 0) * 256 + c], w01 = a.in[I_DW0][(l * 2 + 1) * 256 + c];
    const float a00 = a.in[I_IA0][(l * 2 + 0) * 256 + c], a01 = a.in[I_IA0][(l * 2 + 1) * 256 + c];
    const float* dw1 = a.in[I_DW1] + (size_t)l * 2 * 256 * 32; const float* ia1 = a.in[I_IA1] + (size_t)l * 2 * 256 * 32; const float* gg1 = a.in[I_GG1] + (size_t)l * 256 * 64;
    const float* dw2 = a.in[I_DW2] + (size_t)l * 2 * 32 * 256; const float* ia2 = a.in[I_IA2] + (size_t)l * 2 * 32 * 256; const float* gg2 = a.in[I_GG2] + (size_t)l * 64 * 256;
    for (int tile = bx_opq(); tile < MT / 16; tile += gridDim.x) {
        const int row0 = tile * 16;
        const bool lat = row0 < ML;
        const int base = lat ? (row0 & ~4095) : (ML + ((row0 - ML) & ~255)), T = lat ? SEQ : CTXL;
#pragma unroll
        for (int tt = 0; tt < 8; ++tt) {
            const int ti = th * 8 + tt, row = row0 + ti, t = row - base;
            const float uc = bf2f(Z[(size_t)row * ZW + 1280 + c]);
            const float up = t > 0 ? bf2f(Z[(size_t)(row - 1) * ZW + 1280 + c]) : 0.f, un = t < T - 1 ? bf2f(Z[(size_t)(row + 1) * ZW + 1280 + c]) : 0.f;
            const float du = 0.5f * (up + un) - uc;
            Xs[(0 * 16 + ti) * 256 + c] = uc + du * mu3; Xs[(1 * 16 + ti) * 256 + c] = uc + du * mu4; Xs[(2 * 16 + ti) * 256 + c] = uc + du * mu5;
        }
        __syncthreads();
#pragma unroll 1
        for (int i = 0; i < 6; ++i) {
            const int o = tid + 512 * i, ti = o / 192, j = o % 192;
            const float* W; int R, jj, m;
            if (j < 64) { m = 0; R = 32; jj = j & 31; W = dw1 + (size_t)(j >> 5) * 256 * 32; }
            else if (j < 128) { m = 1; R = 32; jj = j & 31; W = ia1 + (size_t)((j - 64) >> 5) * 256 * 32; }
            else { m = 2; R = 64; jj = j - 128; W = gg1; }
            const float* xs = Xs + (m * 16 + ti) * 256;
            float acc = 0.f;
            for (int k = 0; k < 256; ++k) acc += xs[k] * W[k * R + jj];
            Ps[ti * 192 + j] = j < 64 ? tanhf(acc) : (j < 128 ? acc : sigm(acc));
        }
        __syncthreads();
        float aw0[8], aw1[8], aa0[8], aa1[8], ag[8];
#pragma unroll
        for (int tt = 0; tt < 8; ++tt) { aw0[tt] = 0.f; aw1[tt] = 0.f; aa0[tt] = 0.f; aa1[tt] = 0.f; ag[tt] = 0.f; }
        for (int j = 0; j < 32; ++j) {
            const float w20 = dw2[(size_t)j * 256 + c], w21 = dw2[(size_t)(32 + j) * 256 + c], a20 = ia2[(size_t)j * 256 + c], a21 = ia2[(size_t)(32 + j) * 256 + c];
#pragma unroll
            for (int tt = 0; tt < 8; ++tt) { const float* p = Ps + (th * 8 + tt) * 192;
                aw0[tt] += p[j] * w20; aw1[tt] += p[32 + j] * w21; aa0[tt] += p[64 + j] * a20; aa1[tt] += p[96 + j] * a21; }
        }
        for (int j = 0; j < 64; ++j) { const float g2 = gg2[(size_t)j * 256 + c];
#pragma unroll
            for (int tt = 0; tt < 8; ++tt) ag[tt] += Ps[(th * 8 + tt) * 192 + 128 + j] * g2; }
#pragma unroll
        for (int tt = 0; tt < 8; ++tt) {
            const int row = row0 + th * 8 + tt, t = row - base;
            const bool hp = t > 0, hn = t < T - 1;
            const bf16_t* zc = Z + (size_t)row * ZW + c;
            const float rc = bf2f(zc[512]), kc = bf2f(zc[768]), vc = bf2f(zc[1024]);
            const float rp = hp ? bf2f(zc[512 - ZW]) : 0.f, kp = hp ? bf2f(zc[768 - ZW]) : 0.f, vp = hp ? bf2f(zc[1024 - ZW]) : 0.f;
            const float rn = hn ? bf2f(zc[512 + ZW]) : 0.f, kn = hn ? bf2f(zc[768 + ZW]) : 0.f, vn = hn ? bf2f(zc[1024 + ZW]) : 0.f;
            const float r = rc + (0.5f * (rp + rn) - rc) * mu0, k = kc + (0.5f * (kp + kn) - kc) * mu1, v = vc + (0.5f * (vp + vn) - vc) * mu2;
            float kk = k * kkc; const float nrm = sqrtf(wsum(kk * kk)); kk = kk / fmaxf(nrm, 1e-12f);
            float bsum = 0.f;
            const size_t o = (size_t)row * 256 + c;
#pragma unroll
            for (int d = 0; d < 2; ++d) {
                const float wraw = (d ? w01 : w00) + (d ? aw1[tt] : aw0[tt]);
                const float xs = -wraw, sp = xs > 20.f ? xs : log1pf(__expf(xs));
                const float decay = __expf(-__expf(-sp - 0.5f));
                const float ai = sigm((d ? a01 : a00) + (d ? aa1[tt] : aa0[tt]));
                const float kd = k * (1.0f + (ai - 1.0f) * kac);
                RW[(size_t)(RW_W0 + d) * RWA + o] = decay; RW[(size_t)(RW_KD0 + d) * RWA + o] = kd; RW[(size_t)(RW_B0 + d) * RWA + o] = kk * ai;
                bsum += wsum(r * kd * rkc);
            }
            RW[(size_t)RW_R * RWA + o] = r; RW[(size_t)RW_V * RWA + o] = v; RW[(size_t)RW_KK * RWA + o] = kk;
            BON[o] = f2bf(bsum * v); GG[o] = f2bf(ag[tt]);
        }
        __syncthreads();
    }
}

__device__ __forceinline__ int seqrow(int dir, int b, int s) {
    if (s < CTXL) return ML + b * CTXL + (dir ? CTXL - 1 - s : s);
    const int t = s - CTXL; return b * SEQ + (dir ? SEQ - 1 - t : t);
}
__device__ __forceinline__ float rdl(float v, int k) { return __int_as_float(__builtin_amdgcn_readlane(__float_as_int(v), k)); }
template <bool DOP, bool DOU, bool EMIT>
__device__ __forceinline__ void scan_steps(float (&sp)[64], float (&su)[64], int dir, int b, int h, int s0, int ns, const float* KK, const float* Wd, const float* Bd, const float* KDd,
                                           const float* Vv, const float* Rr, float* Yd, int lane) {
    size_t off = (size_t)seqrow(dir, b, s0) * 256 + h * 64 + lane;
    float xk = KK[off], xw = Wd[off], xb = Bd[off], xd = DOU ? KDd[off] : 0.f, xv = DOU ? Vv[off] : 0.f, xr = EMIT ? Rr[off] : 0.f;
#pragma unroll 1
    for (int s = s0; s < s0 + ns; ++s) {
        const size_t offc = off;
        const float ck = xk, cw = xw, cb = xb, cd = xd, cv = xv, cr = xr;
        if (s + 1 < s0 + ns) {
            off = (size_t)seqrow(dir, b, s + 1) * 256 + h * 64 + lane;
            xk = KK[off]; xw = Wd[off]; xb = Bd[off]; if (DOU) { xd = KDd[off]; xv = Vv[off]; } if (EMIT) xr = Rr[off];
        }
        float pa0 = 0.f, pa1 = 0.f, ua0 = 0.f, ua1 = 0.f;
#pragma unroll
        for (int k = 0; k < 64; k += 2) { const float k0 = rdl(ck, k), k1 = rdl(ck, k + 1);
            if (DOP) { pa0 = fmaf(sp[k], k0, pa0); pa1 = fmaf(sp[k + 1], k1, pa1); }
            if (DOU) { ua0 = fmaf(su[k], k0, ua0); ua1 = fmaf(su[k + 1], k1, ua1); } }
        const float sap = -(pa0 + pa1), sau = -(ua0 + ua1);
        float y0 = 0.f, y1 = 0.f;
#pragma unroll
        for (int k = 0; k < 64; k += 2) {
            const float w0 = rdl(cw, k), w1 = rdl(cw, k + 1), b0 = rdl(cb, k), b1 = rdl(cb, k + 1);
            if (DOP) { sp[k] = fmaf(sp[k], w0, sap * b0); sp[k + 1] = fmaf(sp[k + 1], w1, sap * b1); }
            if (DOU) { const float d0 = rdl(cd, k), d1 = rdl(cd, k + 1);
                const float n0 = fmaf(cv, d0, fmaf(su[k], w0, sau * b0)), n1 = fmaf(cv, d1, fmaf(su[k + 1], w1, sau * b1));
                su[k] = n0; su[k + 1] = n1;
                if (EMIT) { y0 = fmaf(n0, rdl(cr, k), y0); y1 = fmaf(n1, rdl(cr, k + 1), y1); } }
        }
        if (EMIT) Yd[offc] = y0 + y1;
    }
}

__device__ void scan_pass1(CArgs& a) {
    unsigned char* ws = a.ws;
    const float* RW = (const float*)(ws + OFF_RW);
    float* PST = (float*)(ws + OFF_PST); float* UST = (float*)(ws + OFF_UST);
    const int tid = tid_opq(), lane = tid & 63, wid = __builtin_amdgcn_readfirstlane(tid >> 6);
    if (wid >= 4) return;
    for (int task = bx_opq() * 4 + wid; task < 32 * (NCH - 1); task += gridDim.x * 4) {
        const int c = task % (NCH - 1), seq = task / (NCH - 1), dir = seq >> 4, bh = seq & 15, b = bh >> 2, h = bh & 3;
        float sp[64], su[64];
#pragma unroll
        for (int k = 0; k < 64; ++k) { sp[k] = (k == lane) ? 1.f : 0.f; su[k] = 0.f; }
        scan_steps<true, true, false>(sp, su, dir, b, h, c * CHL, CHL, RW + (size_t)RW_KK * RWA, RW + (size_t)(RW_W0 + dir) * RWA, RW + (size_t)(RW_B0 + dir) * RWA,
                                      RW + (size_t)(RW_KD0 + dir) * RWA, RW + (size_t)RW_V * RWA, RW, nullptr, lane);
        float* dp = PST + ((size_t)(seq * NCH + c) * 64 + lane) * 64; float* du = UST + ((size_t)(seq * NCH + c) * 64 + lane) * 64;
#pragma unroll
        for (int q = 0; q < 16; ++q) { f4v o; o.x = sp[4 * q]; o.y = sp[4 * q + 1]; o.z = sp[4 * q + 2]; o.w = sp[4 * q + 3]; *(f4v*)(dp + 4 * q) = o;
            f4v p; p.x = su[4 * q]; p.y = su[4 * q + 1]; p.z = su[4 * q + 2]; p.w = su[4 * q + 3]; *(f4v*)(du + 4 * q) = p; }
    }
}

__device__ void scan_pass2(CArgs& a, float* sm) {
    unsigned char* ws = a.ws;
    const float* PST = (const float*)(ws + OFF_PST); const float* UST = (const float*)(ws + OFF_UST); float* SST = (float*)(ws + OFF_SST);
    float* S = sm;
    float* Pm = sm + 64 * 65;
    const int tid = tid_opq(), i = tid >> 3, kq = tid & 7;
    for (int seq = bx_opq(); seq < 32; seq += gridDim.x) {
        __syncthreads();
        { const float* u0 = UST + (size_t)(seq * NCH + 0) * 4096 + i * 64 + kq * 8; float* d = SST + (size_t)(seq * NCH + 1) * 4096 + i * 64 + kq * 8;
#pragma unroll
          for (int e = 0; e < 8; ++e) { const float v = u0[e]; S[i * 65 + kq * 8 + e] = v; d[e] = v; } }
        for (int c = 1; c < NCH - 1; ++c) {
            const float* P = PST + (size_t)(seq * NCH + c) * 4096;
#pragma unroll
            for (int e = 0; e < 8; ++e) Pm[tid * 8 + e] = P[tid * 8 + e];
            __syncthreads();
            const float* uc = UST + (size_t)(seq * NCH + c) * 4096 + i * 64 + kq * 8;
            float acc[8];
#pragma unroll
            for (int e = 0; e < 8; ++e) acc[e] = uc[e];
            for (int j = 0; j < 64; ++j) { const float sv = S[i * 65 + j];
#pragma unroll
                for (int e = 0; e < 8; ++e) acc[e] = fmaf(sv, Pm[j * 64 + kq * 8 + e], acc[e]); }
            __syncthreads();
            float* d = SST + (size_t)(seq * NCH + c + 1) * 4096 + i * 64 + kq * 8;
#pragma unroll
            for (int e = 0; e < 8; ++e) { S[i * 65 + kq * 8 + e] = acc[e]; d[e] = acc[e]; }
            __syncthreads();
        }
    }
}

__device__ void scan_pass3(CArgs& a) {
    unsigned char* ws = a.ws;
    const float* RW = (const float*)(ws + OFF_RW);
    const float* SST = (const float*)(ws + OFF_SST); float* YS = (float*)(ws + OFF_YS);
    const int tid = tid_opq(), lane = tid & 63, wid = __builtin_amdgcn_readfirstlane(tid >> 6);
    if (wid >= 4) return;
    for (int task = bx_opq() * 4 + wid; task < 32 * NCH; task += gridDim.x * 4) {
        const int c = task % NCH, seq = task / NCH, dir = seq >> 4, bh = seq & 15, b = bh >> 2, h = bh & 3;
        float st[64];
        if (c == 0) {
#pragma unroll
            for (int k = 0; k < 64; ++k) st[k] = 0.f;
        } else { const float* src = SST + ((size_t)(seq * NCH + c) * 64 + lane) * 64;
#pragma unroll
            for (int q = 0; q < 16; ++q) { const f4v v = *(const f4v*)(src + 4 * q); st[4 * q] = v.x; st[4 * q + 1] = v.y; st[4 * q + 2] = v.z; st[4 * q + 3] = v.w; } }
        scan_steps<false, true, true>(st, st, dir, b, h, c * CHL, CHL, RW + (size_t)RW_KK * RWA, RW + (size_t)(RW_W0 + dir) * RWA, RW + (size_t)(RW_B0 + dir) * RWA,
                                      RW + (size_t)(RW_KD0 + dir) * RWA, RW + (size_t)RW_V * RWA, RW + (size_t)RW_R * RWA, YS + (size_t)dir * RWA, lane);
    }
}

__device__ void finalize_phase(CArgs& a, int l) {
    unsigned char* ws = a.ws;
    const float* YS = (const float*)(ws + OFF_YS); const bf16_t* BON = (const bf16_t*)(ws + OFF_BON); const bf16_t* GG = (const bf16_t*)(ws + OFF_G);
    const float* PART = (const float*)(ws + OFF_PART); const float* PARTC = (const float*)(ws + OFF_PARTC); bf16_t* CC = (bf16_t*)(ws + OFF_CONCAT);
    const int ch = tid_opq() & 255;
    const float gng = a.in[I_GNG][l * 256 + ch], gnb = a.in[I_GNB][l * 256 + ch];
    for (int pr = bx_opq(); pr < MT / 2; pr += gridDim.x) {
        const int row = pr * 2 + (tid_opq() >> 8);
        const size_t o = (size_t)row * 256 + ch;
        const float y = YS[o] + YS[RWA + o];
        const float mean = wsum(y) * (1.0f / 64.0f), d = y - mean, var = wsum(d * d) * (1.0f / 64.0f);
        const float yn = d * rsqrtf(var + 64e-5f) * gng + gnb;
        CC[(size_t)row * DM + 256 + ch] = f2bf((yn + bf2f(BON[o])) * bf2f(GG[o]));
        float f;
        if (row < ML) { const int b = row >> 12, kt = row & 4095; const float* p = PART + (size_t)kt * 1024 + b * 256 + ch;
            f = (p[0] + p[(size_t)4096 * 1024]) + (p[(size_t)2 * 4096 * 1024] + p[(size_t)3 * 4096 * 1024]); }
        else { const int rr = row - ML, b = rr >> 8, kt = rr & 255; f = PARTC[(size_t)kt * 1024 + b * 256 + ch]; }
        CC[(size_t)row * DM + 768 + ch] = f2bf(f);
    }
}

__device__ void attn_phase(CArgs& a, int l, unsigned char* lds) {
    unsigned char* ws = a.ws;
    const bf16_t* Q = (const bf16_t*)(ws + OFF_Q); const bf16_t* QC = (const bf16_t*)(ws + OFF_QC); const bf16_t* Kb = (const bf16_t*)(ws + OFF_K); const bf16_t* VT = (const bf16_t*)(ws + OFF_VT);
    bf16_t* CC = (bf16_t*)(ws + OFF_CONCAT);
    unsigned* ctr = (unsigned*)(ws + OFF_CTL) + l;
    bf16_t* Ks = (bf16_t*)lds;
    bf16_t* Vs = (bf16_t*)(lds + 64 * 72 * 2);
    volatile int* qslot = (volatile int*)(lds + 2 * 64 * 72 * 2);
    const int tid = tid_opq(), lane = tid & 63, wid = tid >> 6, lq = lane & 15, quad = lane >> 4;
    const int sr = tid >> 3, sc8 = (tid & 7) * 8;
    for (;;) {
        __syncthreads();
        if (tid == 0) *qslot = (int)atomicAdd(ctr, 1u);
        __syncthreads();
        const int u = *qslot;
        if (u >= 544) break;
        int b, hq, t0, nt, orow; const bf16_t* qp;
        if (u < 512) { b = u >> 7; hq = (u >> 5) & 3; t0 = (u & 31) * 128; nt = TK / 64; qp = Q + ((size_t)(b * 4 + hq) * SEQ + t0) * 64; orow = b * SEQ + t0; }
        else { const int uu = u - 512; b = uu >> 3; hq = (uu >> 1) & 3; t0 = (uu & 1) * 128; nt = CTXL / 64; qp = QC + ((size_t)(b * 4 + hq) * CTXL + t0) * 64; orow = ML + b * CTXL + t0; }
        const int kvh = hq >> 1;
        const bf16_t* kp = Kb + (size_t)(b * 2 + kvh) * TK * 64; const bf16_t* vp = VT + (size_t)(b * 2 + kvh) * 64 * TK;
        s16x8 qf[2];
#pragma unroll
        for (int ds = 0; ds < 2; ++ds) qf[ds] = *(const s16x8*)(qp + (size_t)(wid * 16 + lq) * 64 + ds * 32 + quad * 8);
        f4v o[4];
#pragma unroll
        for (int db = 0; db < 4; ++db) o[db] = (f4v){0.f, 0.f, 0.f, 0.f};
        float mrun = -1e30f, lrun = 0.f;
        u32x4v kreg = *(const u32x4v*)(kp + (size_t)sr * 64 + sc8), vreg = *(const u32x4v*)(vp + (size_t)sr * TK + sc8);
        for (int kt = 0; kt < nt; ++kt) {
            __syncthreads();
            *(u32x4v*)(Ks + sr * 72 + sc8) = kreg; *(u32x4v*)(Vs + sr * 72 + sc8) = vreg;
            __syncthreads();
            if (kt + 1 < nt) { kreg = *(const u32x4v*)(kp + (size_t)((kt + 1) * 64 + sr) * 64 + sc8); vreg = *(const u32x4v*)(vp + (size_t)sr * TK + (kt + 1) * 64 + sc8); }
            f4v s[4];
#pragma unroll
            for (int nb = 0; nb < 4; ++nb) {
                f4v acc = (f4v){0.f, 0.f, 0.f, 0.f};
#pragma unroll
                for (int ds = 0; ds < 2; ++ds) { const s16x8 kf = *(const s16x8*)(Ks + (nb * 16 + lq) * 72 + ds * 32 + quad * 8);
                    acc = __builtin_amdgcn_mfma_f32_16x16x32_bf16(kf, qf[ds], acc, 0, 0, 0); }
                s[nb] = acc;
            }
            float mx = fmaxf(fmaxf(s[0].x, s[0].y), fmaxf(s[0].z, s[0].w));
#pragma unroll
            for (int nb = 1; nb < 4; ++nb) mx = fmaxf(mx, fmaxf(fmaxf(s[nb].x, s[nb].y), fmaxf(s[nb].z, s[nb].w)));
            mx = fmaxf(mx, __shfl_xor(mx, 16)); mx = fmaxf(mx, __shfl_xor(mx, 32));
            const float mnew = fmaxf(mrun, mx), alpha = __builtin_amdgcn_exp2f(mrun - mnew); mrun = mnew;
            float ls = 0.f;
#pragma unroll
            for (int nb = 0; nb < 4; ++nb) { s[nb].x = __builtin_amdgcn_exp2f(s[nb].x - mnew); s[nb].y = __builtin_amdgcn_exp2f(s[nb].y - mnew);
                s[nb].z = __builtin_amdgcn_exp2f(s[nb].z - mnew); s[nb].w = __builtin_amdgcn_exp2f(s[nb].w - mnew); ls += (s[nb].x + s[nb].y) + (s[nb].z + s[nb].w); }
            lrun = lrun * alpha + ls;
#pragma unroll
            for (int db = 0; db < 4; ++db) o[db] *= alpha;
#pragma unroll
            for (int k2 = 0; k2 < 2; ++k2) {
                u32x4v pw; pw.x = cvt_pk_bf16(s[2 * k2].x, s[2 * k2].y); pw.y = cvt_pk_bf16(s[2 * k2].z, s[2 * k2].w);
                pw.z = cvt_pk_bf16(s[2 * k2 + 1].x, s[2 * k2 + 1].y); pw.w = cvt_pk_bf16(s[2 * k2 + 1].z, s[2 * k2 + 1].w);
                const s16x8 pf = __builtin_bit_cast(s16x8, pw);
#pragma unroll
                for (int db = 0; db < 4; ++db) {
                    const bf16_t* vr = Vs + (db * 16 + lq) * 72 + quad * 4;
                    const u32x2v v0 = *(const u32x2v*)(vr + (2 * k2) * 16), v1 = *(const u32x2v*)(vr + (2 * k2 + 1) * 16);
                    u32x4v vw; vw.x = v0.x; vw.y = v0.y; vw.z = v1.x; vw.w = v1.y;
                    o[db] = __builtin_amdgcn_mfma_f32_16x16x32_bf16(__builtin_bit_cast(s16x8, vw), pf, o[db], 0, 0, 0);
                }
            }
        }
        lrun += __shfl_xor(lrun, 16); lrun += __shfl_xor(lrun, 32);
        const float il = 1.0f / lrun;
        bf16_t* op = CC + (size_t)(orow + wid * 16 + lq) * DM + hq * 64 + quad * 4;
#pragma unroll
        for (int db = 0; db < 4; ++db) { u32x2v w; w.x = cvt_pk_bf16(o[db].x * il, o[db].y * il); w.y = cvt_pk_bf16(o[db].z * il, o[db].w * il); *(u32x2v*)(op + db * 16) = w; }
    }
}

__global__ void __launch_bounds__(512, 2) mega_fwd(Args a_unused) {
    extern __shared__ __attribute__((aligned(16))) unsigned char lds[];
    cg::grid_group grid = cg::this_grid();
    float* sm = (float*)lds;
    PG8_LAS unsigned char* l3 = (PG8_LAS unsigned char*)lds;
    const int lo = KA.ph_lo, hi = KA.ph_hi;
#define G ((int)gridDim.x)
#define bx (bx_opq())
#define ws (KA.ws)
    int ph = 0;
#define PH_BEGIN if (ph >= lo && ph < hi) {
#define PH_END } ++ph; if (ph > lo && ph < hi) grid.sync();
#define H ((bf16_t*)(ws + OFF_H))
#define HID ((bf16_t*)(ws + OFF_HID))
#define Y ((float*)(ws + OFF_Y))

    PH_BEGIN prologue_a(KA, sm); PH_END
    PH_BEGIN rowwise_phase(KA, 0, 0, 0, 0.f, 0, 0, false); PH_END
#pragma unroll 1
    for (int l = 0; l < DEPTH; ++l) {
#pragma unroll 1
        for (int f = 0; f < 2; ++f) {
            if (f == 1) {
                PH_BEGIN { pg8::Gemm g{H, (const bf16_t*)(ws + OFF_WIN) + (size_t)l * NIN * 1024, 1024, 1024, 1024}; pg8::StaticOrder S; S.init(MT, NIN, 1, G, bx);
                    pg8::EpiWin E{(bf16_t*)(ws + OFF_Z), (bf16_t*)(ws + OFF_ZT), (bf16_t*)(ws + OFF_ZTC)};
                    pg8::gemm_phase<pg8::EpiWin, pg8::StaticOrder, true, true>(l3, g, S, E); } PH_END
                PH_BEGIN attn_prep(KA, l); pool_prep(KA); rwkv_prep(KA, l, sm); PH_END
                PH_BEGIN scan_pass1(KA); __syncthreads();
                    { pg8::Gemm g{(const bf16_t*)(ws + OFF_DFT), (const bf16_t*)(ws + OFF_ZT), 8192, 8192, 2048}; pg8::StaticOrder S; S.init(SEQ, 1024, 4, G, bx);
                      pg8::EpiF32 E{(float*)(ws + OFF_PART), 1024, (size_t)SEQ * 1024};
                      pg8::gemm_phase<pg8::EpiF32, pg8::StaticOrder, true, true>(l3, g, S, E); }
                    { pg8::Gemm g{(const bf16_t*)(ws + OFF_DFTC), (const bf16_t*)(ws + OFF_ZTC), 512, 512, 512}; pg8::StaticOrder S; S.init(CTXL, 1024, 1, G, bx);
                      pg8::EpiF32 E{(float*)(ws + OFF_PARTC), 1024, 0};
                      pg8::gemm_phase<pg8::EpiF32, pg8::StaticOrder, true, true>(l3, g, S, E); } PH_END
                PH_BEGIN scan_pass2(KA, sm); attn_phase(KA, l, lds); PH_END
                PH_BEGIN scan_pass3(KA); PH_END
                PH_BEGIN finalize_phase(KA, l); PH_END
                PH_BEGIN { pg8::Gemm g{(const bf16_t*)(ws + OFF_CONCAT), (const bf16_t*)(ws + OFF_WOUT) + (size_t)l * 1024 * 1024, 1024, 1024, 1024}; pg8::StaticOrder S; S.init(MT, 1024, 1, G, bx);
                    pg8::EpiF32 E{Y, 1024, 0};
                    pg8::gemm_phase<pg8::EpiF32, pg8::StaticOrder, true, true>(l3, g, S, E); } PH_END
                PH_BEGIN rowwise_phase(KA, 1, l, 1, 1.0f, l, 2, false); PH_END
            }
            PH_BEGIN { pg8::Gemm g{H, (const bf16_t*)(ws + OFF_WGU) + (size_t)(l * 2 + f) * 5632 * 1024, 1024, 1024, 1024}; pg8::StaticOrder S; S.init(MT, 5632, 1, G, bx);
                pg8::EpiSwiglu E{HID, DFF};
                pg8::gemm_phase<pg8::EpiSwiglu, pg8::StaticOrder, true, true>(l3, g, S, E); } PH_END
            PH_BEGIN { pg8::Gemm g{HID, (const bf16_t*)(ws + OFF_WDN) + (size_t)(l * 2 + f) * 1024 * 2816, 2816, 2816, 2816}; pg8::StaticOrder S; S.init(MT, 1024, 1, G, bx);
                pg8::EpiF32 E{Y, 1024, 0};
                pg8::gemm_phase<pg8::EpiF32, pg8::StaticOrder, true, true>(l3, g, S, E); } PH_END
            PH_BEGIN if (f == 0) rowwise_phase(KA, 1, l, 0, 0.5f, l, 1, false);
                     else rowwise_phase(KA, 1, l, 2, 0.5f, l + 1 < DEPTH ? l + 1 : -1, 0, l + 1 == DEPTH); PH_END
        }
    }
#undef PH_BEGIN
#undef PH_END
#undef G
#undef bx
#undef ws
#undef H
#undef HID
#undef Y
}

constexpr int N_PHASES = 2 + DEPTH * 14;
#ifndef MK_PER_PHASE
#define MK_PER_PHASE 0
#endif

extern "C" void kernel_launch(void* const* d_in, const int* in_sizes, int n_in, void* d_out, int out_size, void* d_ws, size_t ws_size, hipStream_t stream) {
    static int grid = 0;
    if (grid == 0) {
        if (n_in != 31 || ws_size < WS_END) { fprintf(stderr, "kernel_launch: need 31 inputs and %zu bytes of workspace (got %d, %zu)\n", (size_t)WS_END, n_in, ws_size); grid = -1; return; }
        int dev = 0, cus = 0, per_cu = 0;
        hipGetDevice(&dev); hipDeviceGetAttribute(&cus, hipDeviceAttributeMultiprocessorCount, dev);
        if (hipFuncSetAttribute((const void*)mega_fwd, hipFuncAttributeMaxDynamicSharedMemorySize, LDS_BYTES) != hipSuccess) { fprintf(stderr, "kernel_launch: hipFuncSetAttribute failed\n"); grid = -1; return; }
        hipOccupancyMaxActiveBlocksPerMultiprocessor(&per_cu, (const void*)mega_fwd, 512, LDS_BYTES);
        (void)hipGetLastError();
        if (per_cu < 1) fprintf(stderr, "kernel_launch: occupancy query says %d blocks per CU\n", per_cu);
        grid = cus > 0 ? cus : 256;
    }
    if (grid < 0) return;
    Args a{};
    for (int i = 0; i < 31; ++i) a.in[i] = (const float*)d_in[i];
    a.out = (float*)d_out; a.ws = (unsigned char*)d_ws;
#if MK_PER_PHASE
    for (int p = 0; p < N_PHASES; ++p) { a.ph_lo = p; a.ph_hi = p + 1; void* args[] = {&a};
        hipError_t e = hipLaunchCooperativeKernel((const void*)mega_fwd, dim3(grid), dim3(512), args, LDS_BYTES, stream);
        if (e != hipSuccess) { fprintf(stderr, "launch %d failed: %s\n", p, hipGetErrorString(e)); break; } }
#else
    a.ph_lo = 0; a.ph_hi = N_PHASES;
    void* args[] = {&a};
    hipError_t e = hipLaunchCooperativeKernel((const void*)mega_fwd, dim3(grid), dim3(512), args, LDS_BYTES, stream);
    if (e != hipSuccess) fprintf(stderr, "cooperative launch failed: %s (grid %d)\n", hipGetErrorString(e), grid);
#endif
}
```

```cpp
#include <hip/hip_runtime.h>
#include <hip/hip_cooperative_groups.h>
#include <cstdio>
#include <cstdint>
namespace cg = cooperative_groups;

__device__ __forceinline__ int tid_opq() { int t = threadIdx.x; asm volatile("" : "+v"(t)); return t; }
__device__ __forceinline__ int bx_opq() { int t = blockIdx.x; asm volatile("" : "+s"(t)); return t; }
namespace pg8 {
#define PG8_LAS __attribute__((address_space(3)))
typedef unsigned short bf16_t;
typedef short bf16x8 __attribute__((ext_vector_type(8)));
typedef float f32x4 __attribute__((ext_vector_type(4)));
typedef unsigned u32x4 __attribute__((ext_vector_type(4)));
constexpr int BM = 256, BK = 64, HALF = 128, HTB = HALF * BK * 2, STAGE_BYTES = 8 * HTB, NXCD = 8, WGM = 8;

__host__ __device__ __forceinline__ int lds_byte(int r, int c) { const int st = (r >> 4) * 2 + (c >> 5), rr = r & 15, cc = c & 31, ob = rr * 64 + cc * 2; return st * 1024 + (ob ^ (((ob >> 9) & 1) << 5)); }
__host__ __device__ __forceinline__ void stage_rc(int b, int& R, int& C) { const int st = b / 1024, sb = b % 1024, swz = sb ^ (((sb >> 9) & 1) << 5); R = (st >> 1) * 16 + swz / 64; C = (st & 1) * 32 + (swz % 64) / 2; }
__host__ __device__ __forceinline__ int perm32(int rho) { const int n = rho >> 4, i = rho & 15; return 8 * (i >> 2) + 4 * n + (i & 3); }

struct Unit { int pm, pn, ks; };
struct Gemm { const bf16_t* A; const bf16_t* Bt; int lda, ldb, K; };

struct StaticOrder {
    int nM, nN, nNS, nwg, G, c;
    __device__ void init(int M, int N, int nS, int G_, int c_) { nM = M / BM; nN = N / BM; nNS = nN * nS; nwg = nM * nNS; G = G_; c = c_; }
    __device__ bool next(int i, Unit& u) const {
        const long L = (long)i * G + c; if (L >= nwg) return false;
        int wgid = (int)L; { const int q = nwg / NXCD, r = nwg % NXCD, xcd = wgid % NXCD, off = wgid / NXCD; wgid = (xcd < r ? xcd * (q + 1) : r * (q + 1) + (xcd - r) * q) + off; }
        const int nig = WGM * nNS, gid = wgid / nig, fm = gid * WGM, gsz = (nM - fm) < WGM ? (nM - fm) : WGM;
        u.pm = fm + ((wgid % nig) % gsz); const int pc = (wgid % nig) / gsz; u.pn = pc % nN; u.ks = pc / nN; return true;
    }
    __device__ __forceinline__ void a_ready(const Unit&) const {}
    __device__ __forceinline__ void done(const Unit&) const {}
};

__device__ __forceinline__ unsigned cvt_pk_bf16(float lo, float hi) { unsigned r; asm volatile("v_cvt_pk_bf16_f32 %0, %1, %2" : "=v"(r) : "v"(lo), "v"(hi)); return r; }
__device__ __forceinline__ float silu_f(float x) { return x * __builtin_amdgcn_rcpf(1.0f + __builtin_amdgcn_exp2f(-1.4426950408889634f * x)); }

struct EpiSwiglu {
    static constexpr bool PERM = true, AFTER_DRAIN = false;
    bf16_t* O; int ldc;
    __device__ __forceinline__ void operator()(const f32x4 (&acc)[2][2][4][2], const Unit& u, int wr, int wc, int fr, int fq) const {
        const int row0 = u.pm * BM + wr * 64 + fr, col0 = u.pn * HALF + wc * 32 + 8 * fq;
#pragma unroll
        for (int ai = 0; ai < 2; ++ai)
#pragma unroll
            for (int m = 0; m < 4; ++m) {
                bf16_t* rowp = O + (size_t)(row0 + ai * HALF + m * 16) * ldc + col0;
                const f32x4 g0 = acc[ai][0][m][0], g1 = acc[ai][0][m][1], u0 = acc[ai][1][m][0], u1 = acc[ai][1][m][1];
                u32x4 w;
                w.x = cvt_pk_bf16(silu_f(g0[0]) * u0[0], silu_f(g0[1]) * u0[1]); w.y = cvt_pk_bf16(silu_f(g0[2]) * u0[2], silu_f(g0[3]) * u0[3]);
                w.z = cvt_pk_bf16(silu_f(g1[0]) * u1[0], silu_f(g1[1]) * u1[1]); w.w = cvt_pk_bf16(silu_f(g1[2]) * u1[2], silu_f(g1[3]) * u1[3]);
                *(u32x4*)rowp = w;
            }
    }
};
struct EpiF32 {
    static constexpr bool PERM = false, AFTER_DRAIN = false;
    float* O; int ldc; size_t sstride;
    __device__ __forceinline__ void operator()(const f32x4 (&acc)[2][2][4][2], const Unit& u, int wr, int wc, int fr, int fq) const {
        const int row0 = u.pm * BM + wr * 64 + fr, col0 = u.pn * BM + wc * 32 + 4 * fq;
        float* base = O + (size_t)u.ks * sstride;
#pragma unroll
        for (int ai = 0; ai < 2; ++ai)
#pragma unroll
            for (int m = 0; m < 4; ++m) {
                float* rowp = base + (size_t)(row0 + ai * HALF + m * 16) * ldc + col0;
#pragma unroll
                for (int bj = 0; bj < 2; ++bj)
#pragma unroll
                    for (int n = 0; n < 2; ++n) *(f32x4*)(rowp + bj * HALF + n * 16) = acc[ai][bj][m][n];
            }
    }
};
struct EpiWin {
    static constexpr bool PERM = true, AFTER_DRAIN = false;
    bf16_t* Z; bf16_t* ZT; bf16_t* ZTC; bf16_t* PB;
    __device__ __forceinline__ void operator()(const f32x4 (&acc)[2][2][4][2], const Unit& u, int wr, int wc, int fr, int fq) const {
        const int row0 = u.pm * BM + wr * 64 + fr;
        if (u.pn < 7 || u.pn >= 9) {
            const bool isz = u.pn < 7;
            const int col0 = (isz ? u.pn : u.pn - 9) * BM + wc * 32 + 8 * fq; const int ldz = isz ? 1792 : 512; bf16_t* ob = isz ? Z : PB;
#pragma unroll
            for (int ai = 0; ai < 2; ++ai)
#pragma unroll
                for (int m = 0; m < 4; ++m) {
                    bf16_t* rowp = ob + (size_t)(row0 + ai * HALF + m * 16) * ldz + col0;
#pragma unroll
                    for (int bj = 0; bj < 2; ++bj) { const f32x4 v0 = acc[ai][bj][m][0], v1 = acc[ai][bj][m][1]; u32x4 w;
                        w.x = cvt_pk_bf16(v0[0], v0[1]); w.y = cvt_pk_bf16(v0[2], v0[3]); w.z = cvt_pk_bf16(v1[0], v1[1]); w.w = cvt_pk_bf16(v1[2], v1[3]);
                        *(u32x4*)(rowp + bj * HALF) = w; }
                }
        } else {
            const int part = u.pn - 7;
#pragma unroll
            for (int ai = 0; ai < 2; ++ai)
#pragma unroll
                for (int m = 0; m < 4; ++m) {
                    const int row = row0 + ai * HALF + m * 16;
                    bf16_t* base; size_t ld;
                    if (row < 16384) { const int b = row >> 12, t = row & 4095; base = ZT + (size_t)(b * 256) * 8192 + part * 4096 + t; ld = 8192; }
                    else { const int rr = row - 16384, b = rr >> 8, j = rr & 255; base = ZTC + (size_t)(b * 256) * 512 + part * 256 + j; ld = 512; }
#pragma unroll
                    for (int bj = 0; bj < 2; ++bj)
#pragma unroll
                        for (int n = 0; n < 2; ++n) { const f32x4 v = acc[ai][bj][m][n]; const int ch = bj * HALF + wc * 32 + 8 * fq + 4 * n;
                            const unsigned p0 = cvt_pk_bf16(v[0], v[1]), p1 = cvt_pk_bf16(v[2], v[3]);
                            base[(size_t)(ch + 0) * ld] = (bf16_t)(p0 & 0xffffu); base[(size_t)(ch + 1) * ld] = (bf16_t)(p0 >> 16);
                            base[(size_t)(ch + 2) * ld] = (bf16_t)(p1 & 0xffffu); base[(size_t)(ch + 3) * ld] = (bf16_t)(p1 >> 16); }
                }
        }
    }
};

template <class Epi, class Sched, bool ALIGN_EPI = false, bool SP2 = false>
__device__ __forceinline__ void gemm_phase(PG8_LAS unsigned char* lds, const Gemm g, const Sched& S, const Epi& E) {
    const int tid = tid_opq(), wid = __builtin_amdgcn_readfirstlane(tid >> 6), lane = tid & 63, wr = wid >> 2, wc = wid & 3, fr = lane & 15, fq = lane >> 4;
    const int K = g.K, nt = K / BK;
    unsigned voffA[2], voffB[2];
#pragma unroll
    for (int i = 0; i < 2; ++i) { int R, C; stage_rc(tid * 16 + i * 8192, R, C); const int Rb = Epi::PERM ? ((R & ~31) + perm32(R & 31)) : R;
        voffA[i] = (unsigned)(R * g.lda + C) * 2u; voffB[i] = (unsigned)(Rb * g.ldb + C) * 2u; }
    const size_t kstep = (size_t)(BK * 2);
    const size_t hstepA = (size_t)HALF * g.lda * 2, hstepB = (size_t)HALF * g.ldb * 2;
    const size_t tstepA = 2 * hstepA, tstepB = 2 * hstepB, ksb = (size_t)K * 2;
    const unsigned ldsw = (unsigned)wid * 1024u;
    const int aoff = lds_byte(wr * 64 + fr, fq * 8), boff = lds_byte(wc * 32 + fr, fq * 8);
#define PG8_SA(b, h) (((b) * 2 + (h)) * HTB)
#define PG8_SB(b, h) ((4 + (b) * 2 + (h)) * HTB)
#define PG8_STAGE(bufoff, gbase, voff) do { _Pragma("unroll") for (int _i = 0; _i < 2; ++_i) \
        __builtin_amdgcn_global_load_lds((const unsigned*)((const char*)(gbase) + (voff)[_i]), (PG8_LAS unsigned*)(lds + (bufoff) + ldsw + _i * 8192), 16, 0, 0); } while (0)
#define PG8_LDA(dst, b, h) do { _Pragma("unroll") for (int m = 0; m < 4; ++m) _Pragma("unroll") for (int k = 0; k < 2; ++k) dst[m][k] = *(const PG8_LAS bf16x8*)(lds + PG8_SA(b, h) + aoff + m * 2048 + k * 1024); } while (0)
#define PG8_LDB(dst, b, h) do { _Pragma("unroll") for (int n = 0; n < 2; ++n) _Pragma("unroll") for (int k = 0; k < 2; ++k) dst[n][k] = *(const PG8_LAS bf16x8*)(lds + PG8_SB(b, h) + boff + n * 2048 + k * 1024); } while (0)
#define PG8_MMA(ai, bj, At, Bt) do { __builtin_amdgcn_s_setprio(1); _Pragma("unroll") for (int m = 0; m < 4; ++m) _Pragma("unroll") for (int n = 0; n < 2; ++n) _Pragma("unroll") for (int k = 0; k < 2; ++k) \
        acc[ai][bj][m][n] = __builtin_amdgcn_mfma_f32_16x16x32_bf16(Bt[n][k], At[m][k], acc[ai][bj][m][n], 0, 0, 0); __builtin_amdgcn_s_setprio(0); } while (0)
#define PG8_WAIT_V(n) asm volatile("s_waitcnt vmcnt(" #n ")" ::: "memory")
#define PG8_WAIT_L(n) asm volatile("s_waitcnt lgkmcnt(" #n ")" ::: "memory")
#define PG8_BAR __builtin_amdgcn_s_barrier()
#define PG8_SCHED __builtin_amdgcn_sched_barrier(0)
    Unit cur, nxt; int ui = 0;
    if (!S.next(0, cur)) return;
    f32x4 acc[2][2][4][2];
#pragma unroll
    for (int a = 0; a < 2; ++a)
#pragma unroll
        for (int b = 0; b < 2; ++b)
#pragma unroll
            for (int m = 0; m < 4; ++m)
#pragma unroll
                for (int n = 0; n < 2; ++n) acc[a][b][m][n] = (f32x4){0.f, 0.f, 0.f, 0.f};
    bf16x8 At[4][2], B0[2][2], B1[2][2];
    const char* cA = (const char*)g.A + (size_t)cur.pm * tstepA + (size_t)cur.ks * ksb; const char* cB = (const char*)g.Bt + (size_t)cur.pn * tstepB + (size_t)cur.ks * ksb;
    S.a_ready(cur);
    if constexpr (SP2) {
        PG8_STAGE(PG8_SB(0, 0), cB, voffB); PG8_STAGE(PG8_SB(0, 1), cB + hstepB, voffB); PG8_STAGE(PG8_SA(0, 0), cA, voffA); PG8_STAGE(PG8_SA(0, 1), cA + hstepA, voffA);
        if (wr == 1) PG8_BAR;
        PG8_WAIT_V(2); PG8_BAR;
        PG8_STAGE(PG8_SB(1, 0), cB + kstep, voffB); PG8_STAGE(PG8_SA(1, 0), cA + kstep, voffA); PG8_STAGE(PG8_SB(1, 1), cB + hstepB + kstep, voffB);
        PG8_WAIT_V(6); PG8_BAR;
    } else {
        PG8_STAGE(PG8_SB(0, 0), cB, voffB); PG8_STAGE(PG8_SA(0, 0), cA, voffA); PG8_STAGE(PG8_SB(0, 1), cB + hstepB, voffB); PG8_STAGE(PG8_SA(0, 1), cA + hstepA, voffA);
        if (wr == 1) PG8_BAR;
        PG8_WAIT_V(4); PG8_BAR;
        PG8_STAGE(PG8_SB(1, 0), cB + kstep, voffB); PG8_STAGE(PG8_SA(1, 0), cA + kstep, voffA); PG8_STAGE(PG8_SB(1, 1), cB + hstepB + kstep, voffB);
        PG8_WAIT_V(6); PG8_BAR;
    }
    for (;;) {
        const bool has_next = S.next(ui + 1, nxt);
        const char* nA = has_next ? (const char*)g.A + (size_t)nxt.pm * tstepA + (size_t)nxt.ks * ksb : cA; const char* nB = has_next ? (const char*)g.Bt + (size_t)nxt.pn * tstepB + (size_t)nxt.ks * ksb : cB;
        for (int t = 0; t < nt; t += 2) {
            const bool last = (t == nt - 2);
            const char* a1 = cA + (size_t)(t + 1) * kstep;
            const char* a2 = last ? nA : cA + (size_t)(t + 2) * kstep; const char* b2 = last ? nB : cB + (size_t)(t + 2) * kstep;
            const char* a3 = a2 + kstep; const char* b3 = b2 + kstep;
            if (last && has_next) S.a_ready(nxt);
            if constexpr (SP2) {
            PG8_LDB(B0, 0, 0); PG8_LDB(B1, 0, 1); PG8_SCHED; PG8_LDA(At, 0, 0); PG8_STAGE(PG8_SA(1, 1), a1 + hstepA, voffA);
            PG8_WAIT_V(8); PG8_WAIT_L(0); PG8_BAR; PG8_MMA(0, 0, At, B0); PG8_MMA(0, 1, At, B1); PG8_BAR; PG8_SCHED;
            PG8_LDA(At, 0, 1); PG8_STAGE(PG8_SB(0, 0), b2, voffB); PG8_STAGE(PG8_SB(0, 1), b2 + hstepB, voffB); PG8_STAGE(PG8_SA(0, 0), a2, voffA);
            PG8_WAIT_V(8); PG8_WAIT_L(0); PG8_BAR; PG8_MMA(1, 0, At, B0); PG8_MMA(1, 1, At, B1); PG8_BAR; PG8_SCHED;
            PG8_LDB(B0, 1, 0); PG8_LDB(B1, 1, 1); PG8_SCHED; PG8_LDA(At, 1, 0); PG8_STAGE(PG8_SA(0, 1), a2 + hstepA, voffA);
            PG8_WAIT_V(8); PG8_WAIT_L(0); PG8_BAR; PG8_MMA(0, 0, At, B0); PG8_MMA(0, 1, At, B1); PG8_BAR; PG8_SCHED;
            PG8_LDA(At, 1, 1); PG8_STAGE(PG8_SB(1, 0), b3, voffB); PG8_STAGE(PG8_SB(1, 1), b3 + hstepB, voffB); PG8_STAGE(PG8_SA(1, 0), a3, voffA);
            PG8_WAIT_V(8); PG8_WAIT_L(0); PG8_BAR; PG8_MMA(1, 0, At, B0); PG8_MMA(1, 1, At, B1); PG8_BAR; PG8_SCHED;
            } else {
            PG8_LDB(B0, 0, 0); PG8_SCHED; PG8_LDA(At, 0, 0); PG8_STAGE(PG8_SA(1, 1), a1 + hstepA, voffA);
            PG8_WAIT_L(8); PG8_BAR; PG8_WAIT_L(0); PG8_MMA(0, 0, At, B0); PG8_BAR; PG8_SCHED;
            PG8_LDB(B1, 0, 1); PG8_STAGE(PG8_SB(0, 0), b2, voffB);
            PG8_BAR; PG8_WAIT_L(0); PG8_MMA(0, 1, At, B1); PG8_BAR;
            PG8_LDA(At, 0, 1); PG8_STAGE(PG8_SA(0, 0), a2, voffA);
            PG8_BAR; PG8_WAIT_L(0); PG8_MMA(1, 0, At, B0); PG8_BAR; PG8_SCHED;
            PG8_STAGE(PG8_SB(0, 1), b2 + hstepB, voffB);
            PG8_WAIT_V(6); PG8_BAR; PG8_MMA(1, 1, At, B1); PG8_BAR;
            PG8_LDB(B0, 1, 0); PG8_SCHED; PG8_LDA(At, 1, 0); PG8_STAGE(PG8_SA(0, 1), a2 + hstepA, voffA);
            PG8_WAIT_L(8); PG8_BAR; PG8_WAIT_L(0); PG8_MMA(0, 0, At, B0); PG8_BAR; PG8_SCHED;
            PG8_LDB(B1, 1, 1); PG8_STAGE(PG8_SB(1, 0), b3, voffB);
            PG8_BAR; PG8_WAIT_L(0); PG8_MMA(0, 1, At, B1); PG8_BAR;
            PG8_LDA(At, 1, 1); PG8_STAGE(PG8_SA(1, 0), a3, voffA);
            PG8_BAR; PG8_WAIT_L(0); PG8_MMA(1, 0, At, B0); PG8_BAR; PG8_SCHED;
            PG8_STAGE(PG8_SB(1, 1), b3 + hstepB, voffB);
            PG8_WAIT_V(6); PG8_BAR; PG8_MMA(1, 1, At, B1); PG8_BAR;
            }
        }
        if constexpr (ALIGN_EPI) { if (wr == 0) PG8_BAR; }
        if constexpr (!Epi::AFTER_DRAIN) { E(acc, cur, wr, wc, fr, fq); S.done(cur); }
        if (!has_next) break;
#pragma unroll
        for (int a = 0; a < 2; ++a)
#pragma unroll
            for (int b = 0; b < 2; ++b)
#pragma unroll
                for (int m = 0; m < 4; ++m)
#pragma unroll
                    for (int n = 0; n < 2; ++n) acc[a][b][m][n] = (f32x4){0.f, 0.f, 0.f, 0.f};
        cur = nxt; cA = nA; cB = nB; ++ui;
        if constexpr (ALIGN_EPI) { if (wr == 1) PG8_BAR; }
    }
    PG8_WAIT_V(0);
    if constexpr (!ALIGN_EPI) { if (wr == 0) PG8_BAR; }
    PG8_BAR;
    if constexpr (Epi::AFTER_DRAIN) { E.fused(acc, cur, wr, wc, fr, fq, lds, wid, lane); S.done(cur); }
#undef PG8_SA
#undef PG8_SB
#undef PG8_STAGE
#undef PG8_LDA
#undef PG8_LDB
#undef PG8_MMA
#undef PG8_WAIT_V
#undef PG8_WAIT_L
#undef PG8_BAR
#undef PG8_SCHED
}
}

using pg8::bf16_t;
using pg8::cvt_pk_bf16;
typedef float f4v __attribute__((ext_vector_type(4)));
typedef short s16x8 __attribute__((ext_vector_type(8)));
typedef short s16x4 __attribute__((ext_vector_type(4)));
typedef unsigned u32x4v __attribute__((ext_vector_type(4)));
typedef unsigned u32x2v __attribute__((ext_vector_type(2)));
#define LAS __attribute__((address_space(3)))

constexpr int DM = 1024, NBAT = 4, SEQ = 4096, DEPTH = 4, CTXL = 256, DFF = 2816;
constexpr int ML = NBAT * SEQ, MC = NBAT * CTXL, MT = ML + MC;
constexpr int NIN = 2816, ZW = 1792, TK = SEQ + CTXL;
constexpr int NCH = 32, CHL = TK / NCH;
constexpr float ALPHA = 1.681792830507429f;
constexpr float QSCALE = 0.125f * 1.4426950408889634f;

constexpr size_t MiB = 1u << 20;
constexpr size_t OFF_CTL = 0, OFF_MOD = 1 * MiB, OFF_WGU = 2 * MiB, OFF_WDN = 90 * MiB, OFF_WIN = 134 * MiB, OFF_WOUT = 156 * MiB,
                 OFF_DFT = 164 * MiB, OFF_DFTC = 228 * MiB, OFF_X = 229 * MiB, OFF_H = 297 * MiB, OFF_Y = 331 * MiB, OFF_HID = 399 * MiB,
                 OFF_Z = 399 * MiB, OFF_ZT = 459 * MiB, OFF_ZTC = 475 * MiB, OFF_Q = 476 * MiB, OFF_QC = 484 * MiB, OFF_K = 485 * MiB, OFF_VT = 490 * MiB,
                 OFF_RW = 495 * MiB, OFF_BON = 648 * MiB, OFF_G = 657 * MiB, OFF_PST = 666 * MiB, OFF_UST = 682 * MiB, WS_END = 698 * MiB;
constexpr size_t OFF_CONCAT = OFF_H, OFF_PART = OFF_Y, OFF_PARTC = OFF_Y + 64 * MiB, OFF_YS = OFF_Z, OFF_SST = OFF_ZT;
constexpr size_t OFF_PB = OFF_Y;
static_assert((size_t)32 * NCH * 4096 * 4 <= 16 * MiB, "chunk-state buffers are 16 MiB each");
constexpr int CTL_BAR = 4096;
constexpr size_t CTL_ZERO_BYTES = 65536;
constexpr size_t RWA = (size_t)MT * 256;
enum { RW_R = 0, RW_V, RW_KK, RW_W0, RW_W1, RW_KD0, RW_KD1, RW_B0, RW_B1 };
constexpr int LDS_BYTES = 147456;

struct Args { const float* in[31]; float* out; unsigned char* ws; int ph_lo, ph_hi; };
typedef const Args __attribute__((address_space(4))) CArgs;
__device__ __forceinline__ CArgs* kargs() { unsigned long long v = (unsigned long long)__builtin_amdgcn_kernarg_segment_ptr(); asm volatile("" : "+s"(v)); return (CArgs*)v; }
#define KA (*kargs())
enum { I_X = 0, I_C, I_CTX, I_CCTX, I_WMOD, I_BMOD, I_LNG, I_LNB, I_WFI, I_WFO, I_WIN, I_QG, I_KG, I_MU, I_DW0, I_DW1, I_DW2, I_IA0, I_IA1, I_IA2, I_GG1, I_GG2,
       I_KK, I_KA, I_RK, I_GNG, I_GNB, I_PW, I_PS, I_FW, I_WOUT };

__device__ __forceinline__ float bf2f(bf16_t u) { return __uint_as_float((unsigned)u << 16); }
__device__ __forceinline__ bf16_t f2bf(float f) { const unsigned u = __float_as_uint(f); return (bf16_t)((u + 0x7fffu + ((u >> 16) & 1u)) >> 16); }
__device__ __forceinline__ float wsum(float v) {
#pragma unroll
    for (int o = 32; o; o >>= 1) v += __shfl_xor(v, o);
    return v;
}
__device__ __forceinline__ float sigm(float x) { return 1.0f / (1.0f + __expf(-x)); }

__device__ __forceinline__ void tcvt_tile(const float* __restrict__ src, int src_ld, int k0, int c0, bf16_t* __restrict__ dst, int dst_ld, int n0, float* tile) {
    const int tid = tid_opq();
#pragma unroll
    for (int i = 0; i < 8; ++i) { const int k = i * 8 + (tid >> 6), n = tid & 63; tile[k * 65 + n] = src[(size_t)(k0 + k) * src_ld + c0 + n]; }
    __syncthreads();
#pragma unroll
    for (int i = 0; i < 4; ++i) { const int n = i * 16 + (tid >> 5), k = (tid & 31) * 2;
        *(unsigned*)(dst + (size_t)(n0 + n) * dst_ld + k0 + k) = cvt_pk_bf16(tile[k * 65 + n], tile[(k + 1) * 65 + n]); }
    __syncthreads();
}

__device__ void prologue_a(CArgs& a, float* sm) {
    unsigned char* ws = a.ws;
    const int tid = tid_opq(), G = gridDim.x, bx = bx_opq();
    bf16_t* WGU = (bf16_t*)(ws + OFF_WGU); bf16_t* WDN = (bf16_t*)(ws + OFF_WDN); bf16_t* WIN = (bf16_t*)(ws + OFF_WIN); bf16_t* WOUT = (bf16_t*)(ws + OFF_WOUT);
    if (bx == 0 && tid < 64) ((unsigned*)(ws + OFF_CTL))[tid] = 0u;
    float* tile = sm;
    for (int j = bx; j < 19200; j += G) {
        if (j < 11264) { const int mat = j / 1408, r = j % 1408, kt = r / 88, nt = r % 88, n0 = nt * 64, pn = n0 >> 8, bj = (n0 >> 7) & 1, i0 = n0 & 127;
            tcvt_tile(a.in[I_WFI] + (size_t)mat * 1024 * 5632, 5632, kt * 64, bj * 2816 + pn * 128 + i0, WGU + (size_t)mat * 5632 * 1024, 1024, n0, tile); }
        else if (j < 16896) { const int jj = j - 11264, mat = jj / 704, r = jj % 704, kt = r / 16, nt = r % 16;
            tcvt_tile(a.in[I_WFO] + (size_t)mat * 2816 * 1024, 1024, kt * 64, nt * 64, WDN + (size_t)mat * 1024 * 2816, 2816, nt * 64, tile); }
        else if (j < 18688) { const int jj = j - 16896, l = jj / 448, r = jj % 448, kt = r / 28, nt = r % 28;
            tcvt_tile(a.in[I_WIN] + (size_t)l * 1024 * 2048, 2048, kt * 64, nt * 64, WIN + (size_t)l * NIN * 1024, 1024, nt * 64, tile); }
        else { const int jj = j - 18688, l = jj / 128, r = jj % 128, kt = r / 16, nt = r % 16;
            tcvt_tile(a.in[I_WOUT] + (size_t)l * 1024 * 1024, 1024, kt * 64, nt * 64, WOUT + (size_t)l * 1024 * 1024, 1024, nt * 64, tile); }
    }
    float* tab = sm;
    float* sc = sm + 4096;
    for (int m = tid; m < 4096; m += 512) tab[m] = cospif((float)m * (1.0f / 2048.0f));
    for (int i = tid; i < 5 * 1024; i += 512) { const float v = i < 4096 ? a.in[I_C][i] : a.in[I_CCTX][i - 4096]; sc[i] = v * sigm(v); }
    __syncthreads();
    const size_t gt = (size_t)bx * 512 + tid, gn = (size_t)G * 512;
    for (size_t idx = gt; idx < (size_t)4 * 1024 * 512; idx += gn) {
        const int kc = idx & 63, g = (idx >> 6) & 3, part = (idx >> 8) & 1, k = (idx >> 9) & 1023, l = (int)(idx >> 19);
        const float* src = a.in[I_WIN] + ((size_t)l * 1024 + k) * 2048 + 1792 + 64 * g;
        float acc = 0.f;
        for (int c = 0; c < 64; ++c) { const int m = ((c * kc) & 63) * 64; const float tr = part ? -tab[(m - 1024) & 4095] : tab[m]; acc += src[c] * tr; }
        WIN[((size_t)l * NIN + 1792 + part * 256 + g * 64 + kc) * 1024 + k] = f2bf(acc);
    }
    for (size_t idx = gt; idx < (size_t)4 * 1024 * 192; idx += gn) {
        const int j = (int)(idx % 192), k = (int)((idx / 192) & 1023), l = (int)(idx / (192 * 1024));
        const float* W1; int R, jj, mi;
        if (j < 64) { mi = 3; R = 32; jj = j & 31; W1 = a.in[I_DW1] + ((size_t)l * 2 + (j >> 5)) * 256 * 32; }
        else if (j < 128) { mi = 4; R = 32; jj = j & 31; W1 = a.in[I_IA1] + ((size_t)l * 2 + ((j - 64) >> 5)) * 256 * 32; }
        else { mi = 5; R = 64; jj = j - 128; W1 = a.in[I_GG1] + (size_t)l * 256 * 64; }
        const float* mu = a.in[I_MU] + ((size_t)l * 6 + mi) * 256;
        const float* src = a.in[I_WIN] + ((size_t)l * 1024 + k) * 2048 + 1280;
        float pa = 0.f, pb = 0.f;
        for (int c = 0; c < 256; ++c) { const float wv = src[c] * W1[c * R + jj], m = mu[c]; pb = fmaf(wv, m, pb); pa = fmaf(wv, 1.0f - m, pa); }
        WIN[((size_t)l * NIN + 2304 + j) * 1024 + k] = f2bf(pa); WIN[((size_t)l * NIN + 2496 + j) * 1024 + k] = f2bf(pb);
    }
    for (size_t idx = gt; idx < (size_t)4 * 128 * 1024; idx += gn) { const int k = idx & 1023, r = (idx >> 10) & 127, l = (int)(idx >> 17); WIN[((size_t)l * NIN + 2688 + r) * 1024 + k] = 0; }
    for (size_t idx = gt; idx < (size_t)4 * 4 * 8 * 1024; idx += gn) {
        const int n = idx & 1023, c8 = (idx >> 10) & 7, g = (idx >> 13) & 3, l = (int)(idx >> 15);
        const float* pw = a.in[I_PW] + (((size_t)l * 4 + g) * 64 + c8 * 8) * 64;
        const float* ps = a.in[I_PS] + l * 256 + 64 * g;
        const float* wo = a.in[I_WOUT] + ((size_t)l * 1024 + 512 + 64 * g) * 1024 + n;
        float acc[8];
#pragma unroll
        for (int e = 0; e < 8; ++e) acc[e] = 0.f;
        for (int d = 0; d < 64; ++d) { const float w = wo[(size_t)d * 1024] * ps[d];
#pragma unroll
            for (int e = 0; e < 8; ++e) acc[e] += pw[e * 64 + d] * w; }
        bf16_t* dst = WOUT + ((size_t)l * 1024 + n) * 1024 + 512 + 64 * g + c8 * 8;
        u32x4v o; o.x = cvt_pk_bf16(acc[0], acc[1]); o.y = cvt_pk_bf16(acc[2], acc[3]); o.z = cvt_pk_bf16(acc[4], acc[5]); o.w = cvt_pk_bf16(acc[6], acc[7]);
        *(u32x4v*)dst = o;
    }
    for (size_t idx = gt; idx < (size_t)4 * 32 * 1024; idx += gn) {
        const int n = idx & 1023, i8 = (idx >> 10) & 31, l = (int)(idx >> 15);
        const float* fw = a.in[I_FW] + ((size_t)l * 256 + i8 * 8) * 256;
        const float* wo = a.in[I_WOUT] + ((size_t)l * 1024 + 768) * 1024 + n;
        float acc[8];
#pragma unroll
        for (int e = 0; e < 8; ++e) acc[e] = 0.f;
        for (int j = 0; j < 256; ++j) { const float w = wo[(size_t)j * 1024];
#pragma unroll
            for (int e = 0; e < 8; ++e) acc[e] += fw[e * 256 + j] * w; }
        bf16_t* dst = WOUT + ((size_t)l * 1024 + n) * 1024 + 768 + i8 * 8;
        u32x4v o; o.x = cvt_pk_bf16(acc[0], acc[1]); o.y = cvt_pk_bf16(acc[2], acc[3]); o.z = cvt_pk_bf16(acc[4], acc[5]); o.w = cvt_pk_bf16(acc[6], acc[7]);
        *(u32x4v*)dst = o;
    }
    {
        bf16_t* DFT = (bf16_t*)(ws + OFF_DFT); bf16_t* DFTC = (bf16_t*)(ws + OFF_DFTC);
        for (size_t idx = gt; idx < (size_t)4096 * 1024; idx += gn) {
            const int kt = (int)(idx >> 10), c8 = (int)(idx & 1023), part = c8 >> 9, t0 = (c8 & 511) * 8;
            float v[8];
#pragma unroll
            for (int e = 0; e < 8; ++e) { const int m = (kt * (t0 + e)) & 4095; v[e] = tab[part ? ((m - 1024) & 4095) : m] * (1.0f / 512.0f); }
            u32x4v o; o.x = cvt_pk_bf16(v[0], v[1]); o.y = cvt_pk_bf16(v[2], v[3]); o.z = cvt_pk_bf16(v[4], v[5]); o.w = cvt_pk_bf16(v[6], v[7]);
            *(u32x4v*)(DFT + (size_t)kt * 8192 + c8 * 8) = o;
        }
        for (size_t idx = gt; idx < (size_t)256 * 64; idx += gn) {
            const int kt = (int)(idx >> 6), c8 = (int)(idx & 63), part = c8 >> 5, t0 = (c8 & 31) * 8;
            float v[8];
#pragma unroll
            for (int e = 0; e < 8; ++e) { const int m = ((kt * (t0 + e)) & 255) * 16; v[e] = tab[part ? ((m - 1024) & 4095) : m] * (1.0f / 128.0f); }
            u32x4v o; o.x = cvt_pk_bf16(v[0], v[1]); o.y = cvt_pk_bf16(v[2], v[3]); o.z = cvt_pk_bf16(v[4], v[5]); o.w = cvt_pk_bf16(v[6], v[7]);
            *(u32x4v*)(DFTC + (size_t)kt * 512 + c8 * 8) = o;
        }
    }
    {
        float* MOD = (float*)(ws + OFF_MOD);
        float* red = sm + 4096 + 5120;
        const int col = tid & 63, kg = tid >> 6;
        for (int it = bx; it < 4 * 144; it += G) {
            const int l = it / 144, n0 = (it % 144) * 64;
            const float* w = a.in[I_WMOD] + ((size_t)l * 1024 + kg * 128) * 9216 + n0 + col;
            float acc[5] = {0.f, 0.f, 0.f, 0.f, 0.f};
            for (int k = 0; k < 128; ++k) { const float wv = w[(size_t)k * 9216];
#pragma unroll
                for (int s = 0; s < 5; ++s) acc[s] += sc[s * 1024 + kg * 128 + k] * wv; }
#pragma unroll
            for (int s = 0; s < 5; ++s) red[(kg * 5 + s) * 64 + col] = acc[s];
            __syncthreads();
            if (tid < 320) { const int s = tid >> 6; float t = a.in[I_BMOD][l * 9216 + n0 + col];
#pragma unroll
                for (int q = 0; q < 8; ++q) t += red[(q * 5 + s) * 64 + col];
                MOD[((size_t)l * 5 + s) * 9216 + n0 + col] = t; }
            __syncthreads();
        }
    }
}

__device__ void rowwise_phase(CArgs& a, int mode, int l, int sub, float resid_w, int nl, int nsub, bool final_out) {
    unsigned char* ws = a.ws;
    const float* MOD = (const float*)(ws + OFF_MOD);
    float* X = (float*)(ws + OFF_X); const float* Y = (const float*)(ws + OFF_Y); bf16_t* H = (bf16_t*)(ws + OFF_H);
    const int lane = tid_opq() & 63, wid = tid_opq() >> 6;
    for (int row = bx_opq() * 8 + wid; row < MT; row += gridDim.x * 8) {
        const int s = row < ML ? (row >> 12) : 4;
        f4v v[4];
        if (mode == 0) {
            const float* src = row < ML ? a.in[I_X] + (size_t)row * DM : a.in[I_CTX] + (size_t)(row - ML) * DM;
#pragma unroll
            for (int q = 0; q < 4; ++q) v[q] = *(const f4v*)(src + q * 256 + lane * 4);
        } else {
            const float* gate = MOD + ((size_t)l * 5 + s) * 9216 + (sub * 3 + 2) * 1024;
            float sum = 0.f;
#pragma unroll
            for (int q = 0; q < 4; ++q) { const int col = q * 256 + lane * 4;
                const f4v x = *(const f4v*)(X + (size_t)row * DM + col), y = *(const f4v*)(Y + (size_t)row * DM + col), g = *(const f4v*)(gate + col);
                v[q] = ALPHA * x + resid_w * (g * y); sum += (v[q].x + v[q].y) + (v[q].z + v[q].w); }
            const float mean = wsum(sum) * (1.0f / 1024.0f);
            float sq = 0.f;
#pragma unroll
            for (int q = 0; q < 4; ++q) { const f4v d = v[q] - mean; sq += (d.x * d.x + d.y * d.y) + (d.z * d.z + d.w * d.w); }
            const float rstd = rsqrtf(wsum(sq) * (1.0f / 1024.0f) + 1e-5f);
            const float* lg = a.in[I_LNG] + ((size_t)l * 3 + sub) * 1024; const float* lb = a.in[I_LNB] + ((size_t)l * 3 + sub) * 1024;
#pragma unroll
            for (int q = 0; q < 4; ++q) { const int col = q * 256 + lane * 4; v[q] = (v[q] - mean) * rstd * *(const f4v*)(lg + col) + *(const f4v*)(lb + col); }
        }
        if (final_out) { if (row < ML) {
#pragma unroll
            for (int q = 0; q < 4; ++q) *(f4v*)(a.out + (size_t)row * DM + q * 256 + lane * 4) = v[q]; } }
        else {
#pragma unroll
            for (int q = 0; q < 4; ++q) *(f4v*)(X + (size_t)row * DM + q * 256 + lane * 4) = v[q]; }
        if (nl >= 0) {
            const float* sh = MOD + ((size_t)nl * 5 + s) * 9216 + (nsub * 3 + 0) * 1024; const float* scl = sh + 1024;
#pragma unroll
            for (int q = 0; q < 4; ++q) { const int col = q * 256 + lane * 4; const f4v h = v[q] * (1.0f + *(const f4v*)(scl + col)) + *(const f4v*)(sh + col);
                u32x2v o; o.x = cvt_pk_bf16(h.x, h.y); o.y = cvt_pk_bf16(h.z, h.w); *(u32x2v*)(H + (size_t)row * DM + col) = o; }
        }
    }
}

__device__ void attn_prep(CArgs& a, int l, float* sm) {
    unsigned char* ws = a.ws;
    const bf16_t* Z = (const bf16_t*)(ws + OFF_Z);
    bf16_t* Q = (bf16_t*)(ws + OFF_Q); bf16_t* QC = (bf16_t*)(ws + OFF_QC); bf16_t* Kb = (bf16_t*)(ws + OFF_K); bf16_t* VT = (bf16_t*)(ws + OFF_VT);
    const int tid = tid_opq(), lane = tid & 63, slot = __builtin_amdgcn_readfirstlane(tid >> 6);
    float* tabc = sm; float* tabs = sm + 64 * 17;
    __syncthreads();
    for (int idx = tid; idx < 1024; idx += 512) { const int pos = idx >> 4, i = idx & 15;
        const float ang = (float)pos * exp2f(-(float)i * (13.287712379549449f / 16.0f));
        float sn, cs; sincosf(ang, &sn, &cs); tabc[pos * 17 + i] = cs; tabs[pos * 17 + i] = sn; }
    __syncthreads();
    const float* gp = slot < 4 ? a.in[I_QG] + l * 64 : a.in[I_KG] + l * 64;
    for (int tile = bx_opq(); tile < MT / 64; tile += gridDim.x) {
        const int row = tile * 64 + lane;
        const bool lat = tile < ML / 64;
        const int b = lat ? (row >> 12) : ((row - ML) >> 8), t = lat ? (row & 4095) : ((row - ML) & 255), pos = lat ? 256 + t : t;
        float x[64];
        const u32x4v* zp = (const u32x4v*)(Z + (size_t)row * ZW + slot * 64);
#pragma unroll
        for (int q = 0; q < 8; ++q) { const u32x4v w = zp[q];
            x[8 * q + 0] = __uint_as_float(w.x << 16); x[8 * q + 1] = __uint_as_float(w.x & 0xffff0000u); x[8 * q + 2] = __uint_as_float(w.y << 16); x[8 * q + 3] = __uint_as_float(w.y & 0xffff0000u);
            x[8 * q + 4] = __uint_as_float(w.z << 16); x[8 * q + 5] = __uint_as_float(w.z & 0xffff0000u); x[8 * q + 6] = __uint_as_float(w.w << 16); x[8 * q + 7] = __uint_as_float(w.w & 0xffff0000u); }
        if (slot < 6) {
            float ss = 0.f;
#pragma unroll
            for (int d = 0; d < 64; ++d) ss = fmaf(x[d], x[d], ss);
            const float sc = rsqrtf(ss * (1.0f / 64.0f) + 1e-6f) * (slot < 4 ? QSCALE : 1.0f);
#pragma unroll
            for (int d = 0; d < 64; ++d) x[d] *= sc * gp[d];
            if (lat) {
                const int rr = t >> 6, cc = t & 63;
#pragma unroll
                for (int i = 0; i < 32; ++i) { const int ti = (i < 16 ? rr : cc) * 17 + (i & 15); const float cs = tabc[ti], sn = tabs[ti];
                    const float x0 = x[2 * i], x1 = x[2 * i + 1]; x[2 * i] = x0 * cs - x1 * sn; x[2 * i + 1] = x0 * sn + x1 * cs; }
            }
            bf16_t* dst = slot < 4 ? (lat ? Q + ((size_t)(b * 4 + slot) * SEQ + t) * 64 : QC + ((size_t)(b * 4 + slot) * CTXL + t) * 64)
                                   : Kb + ((size_t)(b * 2 + (slot - 4)) * TK + pos) * 64;
#pragma unroll
            for (int q = 0; q < 8; ++q) { u32x4v w; w.x = cvt_pk_bf16(x[8 * q], x[8 * q + 1]); w.y = cvt_pk_bf16(x[8 * q + 2], x[8 * q + 3]);
                w.z = cvt_pk_bf16(x[8 * q + 4], x[8 * q + 5]); w.w = cvt_pk_bf16(x[8 * q + 6], x[8 * q + 7]); *(u32x4v*)(dst + 8 * q) = w; }
        } else {
            bf16_t* dst = VT + (size_t)(b * 2 + (slot - 6)) * 64 * TK + pos;
#pragma unroll
            for (int d = 0; d < 64; ++d) dst[(size_t)d * TK] = (bf16_t)(__float_as_uint(x[d]) >> 16);
        }
    }
    __syncthreads();
}

__device__ void pool_prep(CArgs& a) {
    unsigned char* ws = a.ws;
    const bf16_t* Z = (const bf16_t*)(ws + OFF_Z); bf16_t* CC = (bf16_t*)(ws + OFF_CONCAT);
    const int ch = tid_opq() & 255, g = ch >> 6, hw = 1 << g;
    for (int pr = bx_opq(); pr < MT / 2; pr += gridDim.x) {
        const int row = pr * 2 + (tid_opq() >> 8);
        const bool lat = row < ML;
        const int base = lat ? (row & ~4095) : (ML + ((row - ML) & ~255)), T = lat ? SEQ : CTXL, t = row - base;
        const int lo = t - hw < 0 ? 0 : t - hw, hi = t + hw > T ? T : t + hw;
        float sum = 0.f;
        for (int tt = lo; tt < hi; ++tt) sum += bf2f(Z[(size_t)(base + tt) * ZW + 1536 + ch]);
        const float zc = bf2f(Z[(size_t)row * ZW + 1536 + ch]);
        CC[(size_t)row * DM + 512 + ch] = f2bf(sum / (float)(hi - lo) - zc);
    }
}

__device__ void rwkv_prep(CArgs& a, int l, float* sm) {
    unsigned char* ws = a.ws;
    const bf16_t* Z = (const bf16_t*)(ws + OFF_Z);
    float* RW = (float*)(ws + OFF_RW); bf16_t* BON = (bf16_t*)(ws + OFF_BON); bf16_t* GG = (bf16_t*)(ws + OFF_G);
    float* Ps = sm;
    const bf16_t* PB = (const bf16_t*)(ws + OFF_PB);
    const int tid = tid_opq(), c = tid & 255, th = tid >> 8, h = c >> 6;
    const float* mu = a.in[I_MU] + (size_t)l * 6 * 256;
    const float mu0 = mu[c], mu1 = mu[256 + c], mu2 = mu[512 + c];
    const float kkc = a.in[I_KK][l * 256 + c], kac = a.in[I_KA][l * 256 + c], rkc = a.in[I_RK][l * 256 + c];
    const float w00 = a.in[I_DW0][(l * 2 + 0) * 256 + c], w01 = a.in[I_DW0][(l * 2 + 1) * 256 + c];
    const float a00 = a.in[I_IA0][(l * 2 + 0) * 256 + c], a01 = a.in[I_IA0][(l * 2 + 1) * 256 + c];
    const float* dw2 = a.in[I_DW2] + (size_t)l * 2 * 32 * 256; const float* ia2 = a.in[I_IA2] + (size_t)l * 2 * 32 * 256; const float* gg2 = a.in[I_GG2] + (size_t)l * 64 * 256;
    for (int tile = bx_opq(); tile < MT / 16; tile += gridDim.x) {
        const int row0 = tile * 16;
        const bool lat = row0 < ML;
        const int base = lat ? (row0 & ~4095) : (ML + ((row0 - ML) & ~255)), T = lat ? SEQ : CTXL;
#pragma unroll 1
        for (int i = 0; i < 6; ++i) {
            const int o = tid + 512 * i, ti = o / 192, j = o % 192, row = row0 + ti, t = row - base;
            const float pa = bf2f(PB[(size_t)row * 512 + j]);
            const float pp = t > 0 ? bf2f(PB[(size_t)(row - 1) * 512 + 192 + j]) : 0.f, pn = t < T - 1 ? bf2f(PB[(size_t)(row + 1) * 512 + 192 + j]) : 0.f;
            const float acc = pa + 0.5f * (pp + pn);
            Ps[ti * 192 + j] = j < 64 ? tanhf(acc) : (j < 128 ? acc : sigm(acc));
        }
        __syncthreads();
        float aw0[8], aw1[8], aa0[8], aa1[8], ag[8];
#pragma unroll
        for (int tt = 0; tt < 8; ++tt) { aw0[tt] = 0.f; aw1[tt] = 0.f; aa0[tt] = 0.f; aa1[tt] = 0.f; ag[tt] = 0.f; }
        for (int j = 0; j < 32; ++j) {
            const float w20 = dw2[(size_t)j * 256 + c], w21 = dw2[(size_t)(32 + j) * 256 + c], a20 = ia2[(size_t)j * 256 + c], a21 = ia2[(size_t)(32 + j) * 256 + c];
#pragma unroll
            for (int tt = 0; tt < 8; ++tt) { const float* p = Ps + (th * 8 + tt) * 192;
                aw0[tt] += p[j] * w20; aw1[tt] += p[32 + j] * w21; aa0[tt] += p[64 + j] * a20; aa1[tt] += p[96 + j] * a21; }
        }
        for (int j = 0; j < 64; ++j) { const float g2 = gg2[(size_t)j * 256 + c];
#pragma unroll
            for (int tt = 0; tt < 8; ++tt) ag[tt] += Ps[(th * 8 + tt) * 192 + 128 + j] * g2; }
#pragma unroll
        for (int tt = 0; tt < 8; ++tt) {
            const int row = row0 + th * 8 + tt, t = row - base;
            const bool hp = t > 0, hn = t < T - 1;
            const bf16_t* zc = Z + (size_t)row * ZW + c;
            const float rc = bf2f(zc[512]), kc = bf2f(zc[768]), vc = bf2f(zc[1024]);
            const float rp = hp ? bf2f(zc[512 - ZW]) : 0.f, kp = hp ? bf2f(zc[768 - ZW]) : 0.f, vp = hp ? bf2f(zc[1024 - ZW]) : 0.f;
            const float rn = hn ? bf2f(zc[512 + ZW]) : 0.f, kn = hn ? bf2f(zc[768 + ZW]) : 0.f, vn = hn ? bf2f(zc[1024 + ZW]) : 0.f;
            const float r = rc + (0.5f * (rp + rn) - rc) * mu0, k = kc + (0.5f * (kp + kn) - kc) * mu1, v = vc + (0.5f * (vp + vn) - vc) * mu2;
            float kk = k * kkc; const float nrm = sqrtf(wsum(kk * kk)); kk = kk / fmaxf(nrm, 1e-12f);
            float bsum = 0.f;
            const size_t o = (size_t)row * 256 + c;
#pragma unroll
            for (int d = 0; d < 2; ++d) {
                const float wraw = (d ? w01 : w00) + (d ? aw1[tt] : aw0[tt]);
                const float xs = -wraw, sp = xs > 20.f ? xs : log1pf(__expf(xs));
                const float decay = __expf(-__expf(-sp - 0.5f));
                const float ai = sigm((d ? a01 : a00) + (d ? aa1[tt] : aa0[tt]));
                const float kd = k * (1.0f + (ai - 1.0f) * kac);
                RW[(size_t)(RW_W0 + d) * RWA + o] = decay; RW[(size_t)(RW_KD0 + d) * RWA + o] = kd; RW[(size_t)(RW_B0 + d) * RWA + o] = kk * ai;
                bsum += wsum(r * kd * rkc);
            }
            RW[(size_t)RW_R * RWA + o] = r; RW[(size_t)RW_V * RWA + o] = v; RW[(size_t)RW_KK * RWA + o] = kk;
            BON[o] = f2bf(bsum * v); GG[o] = f2bf(ag[tt]);
        }
        __syncthreads();
    }
}

__device__ __forceinline__ int seqrow(int dir, int b, int s) {
    if (s < CTXL) return ML + b * CTXL + (dir ? CTXL - 1 - s : s);
    const int t = s - CTXL; return b * SEQ + (dir ? SEQ - 1 - t : t);
}
__device__ __forceinline__ float rdl(float v, int k) { return __int_as_float(__builtin_amdgcn_readlane(__float_as_int(v), k)); }
template <bool DOP, bool DOU, bool EMIT>
__device__ __forceinline__ void scan_steps(float (&sp)[64], float (&su)[64], int dir, int b, int h, int s0, int ns, const float* KK, const float* Wd, const float* Bd, const float* KDd,
                                           const float* Vv, const float* Rr, float* Yd, int lane) {
    size_t off = (size_t)seqrow(dir, b, s0) * 256 + h * 64 + lane;
    float xk = KK[off], xw = Wd[off], xb = Bd[off], xd = DOU ? KDd[off] : 0.f, xv = DOU ? Vv[off] : 0.f, xr = EMIT ? Rr[off] : 0.f;
#pragma unroll 1
    for (int s = s0; s < s0 + ns; ++s) {
        const size_t offc = off;
        const float ck = xk, cw = xw, cb = xb, cd = xd, cv = xv, cr = xr;
        if (s + 1 < s0 + ns) {
            off = (size_t)seqrow(dir, b, s + 1) * 256 + h * 64 + lane;
            xk = KK[off]; xw = Wd[off]; xb = Bd[off]; if (DOU) { xd = KDd[off]; xv = Vv[off]; } if (EMIT) xr = Rr[off];
        }
        float pa0 = 0.f, pa1 = 0.f, ua0 = 0.f, ua1 = 0.f;
#pragma unroll
        for (int k = 0; k < 64; k += 2) { const float k0 = rdl(ck, k), k1 = rdl(ck, k + 1);
            if (DOP) { pa0 = fmaf(sp[k], k0, pa0); pa1 = fmaf(sp[k + 1], k1, pa1); }
            if (DOU) { ua0 = fmaf(su[k], k0, ua0); ua1 = fmaf(su[k + 1], k1, ua1); } }
        const float sap = -(pa0 + pa1), sau = -(ua0 + ua1);
        float y0 = 0.f, y1 = 0.f;
#pragma unroll
        for (int k = 0; k < 64; k += 2) {
            const float w0 = rdl(cw, k), w1 = rdl(cw, k + 1), b0 = rdl(cb, k), b1 = rdl(cb, k + 1);
            if (DOP) { sp[k] = fmaf(sp[k], w0, sap * b0); sp[k + 1] = fmaf(sp[k + 1], w1, sap * b1); }
            if (DOU) { const float d0 = rdl(cd, k), d1 = rdl(cd, k + 1);
                const float n0 = fmaf(cv, d0, fmaf(su[k], w0, sau * b0)), n1 = fmaf(cv, d1, fmaf(su[k + 1], w1, sau * b1));
                su[k] = n0; su[k + 1] = n1;
                if (EMIT) { y0 = fmaf(n0, rdl(cr, k), y0); y1 = fmaf(n1, rdl(cr, k + 1), y1); } }
        }
        if (EMIT) Yd[offc] = y0 + y1;
    }
}

__device__ void scan_pass1(CArgs& a) {
    unsigned char* ws = a.ws;
    const float* RW = (const float*)(ws + OFF_RW);
    float* PST = (float*)(ws + OFF_PST); float* UST = (float*)(ws + OFF_UST);
    const int tid = tid_opq(), lane = tid & 63, wid = __builtin_amdgcn_readfirstlane(tid >> 6);
    if (wid >= 4) return;
    for (int task = bx_opq() * 4 + wid; task < 32 * (NCH - 1); task += gridDim.x * 4) {
        const int c = task % (NCH - 1), seq = task / (NCH - 1), dir = seq >> 4, bh = seq & 15, b = bh >> 2, h = bh & 3;
        float sp[64], su[64];
#pragma unroll
        for (int k = 0; k < 64; ++k) { sp[k] = (k == lane) ? 1.f : 0.f; su[k] = 0.f; }
        scan_steps<true, true, false>(sp, su, dir, b, h, c * CHL, CHL, RW + (size_t)RW_KK * RWA, RW + (size_t)(RW_W0 + dir) * RWA, RW + (size_t)(RW_B0 + dir) * RWA,
                                      RW + (size_t)(RW_KD0 + dir) * RWA, RW + (size_t)RW_V * RWA, RW, nullptr, lane);
        float* dp = PST + ((size_t)(seq * NCH + c) * 64 + lane) * 64; float* du = UST + ((size_t)(seq * NCH + c) * 64 + lane) * 64;
#pragma unroll
        for (int q = 0; q < 16; ++q) { f4v o; o.x = sp[4 * q]; o.y = sp[4 * q + 1]; o.z = sp[4 * q + 2]; o.w = sp[4 * q + 3]; *(f4v*)(dp + 4 * q) = o;
            f4v p; p.x = su[4 * q]; p.y = su[4 * q + 1]; p.z = su[4 * q + 2]; p.w = su[4 * q + 3]; *(f4v*)(du + 4 * q) = p; }
    }
}

__device__ void scan_pass2(CArgs& a, float* sm) {
    unsigned char* ws = a.ws;
    const float* PST = (const float*)(ws + OFF_PST); const float* UST = (const float*)(ws + OFF_UST); float* SST = (float*)(ws + OFF_SST);
    float* S = sm;
    float* Pm = sm + 64 * 65;
    const int tid = tid_opq(), i = tid >> 3, kq = tid & 7;
    for (int seq = bx_opq(); seq < 32; seq += gridDim.x) {
        __syncthreads();
        { const float* u0 = UST + (size_t)(seq * NCH + 0) * 4096 + i * 64 + kq * 8; float* d = SST + (size_t)(seq * NCH + 1) * 4096 + i * 64 + kq * 8;
#pragma unroll
          for (int e = 0; e < 8; ++e) { const float v = u0[e]; S[i * 65 + kq * 8 + e] = v; d[e] = v; } }
        for (int c = 1; c < NCH - 1; ++c) {
            const float* P = PST + (size_t)(seq * NCH + c) * 4096;
#pragma unroll
            for (int e = 0; e < 8; ++e) Pm[tid * 8 + e] = P[tid * 8 + e];
            __syncthreads();
            const float* uc = UST + (size_t)(seq * NCH + c) * 4096 + i * 64 + kq * 8;
            float acc[8];
#pragma unroll
            for (int e = 0; e < 8; ++e) acc[e] = uc[e];
            for (int j = 0; j < 64; ++j) { const float sv = S[i * 65 + j];
#pragma unroll
                for (int e = 0; e < 8; ++e) acc[e] = fmaf(sv, Pm[j * 64 + kq * 8 + e], acc[e]); }
            __syncthreads();
            float* d = SST + (size_t)(seq * NCH + c + 1) * 4096 + i * 64 + kq * 8;
#pragma unroll
            for (int e = 0; e < 8; ++e) { S[i * 65 + kq * 8 + e] = acc[e]; d[e] = acc[e]; }
            __syncthreads();
        }
    }
}

__device__ void scan_pass3(CArgs& a) {
    unsigned char* ws = a.ws;
    const float* RW = (const float*)(ws + OFF_RW);
    const float* SST = (const float*)(ws + OFF_SST); float* YS = (float*)(ws + OFF_YS);
    const int tid = tid_opq(), lane = tid & 63, wid = __builtin_amdgcn_readfirstlane(tid >> 6);
    if (wid >= 4) return;
    for (int task = bx_opq() * 4 + wid; task < 32 * NCH; task += gridDim.x * 4) {
        const int c = task % NCH, seq = task / NCH, dir = seq >> 4, bh = seq & 15, b = bh >> 2, h = bh & 3;
        float st[64];
        if (c == 0) {
#pragma unroll
            for (int k = 0; k < 64; ++k) st[k] = 0.f;
        } else { const float* src = SST + ((size_t)(seq * NCH + c) * 64 + lane) * 64;
#pragma unroll
            for (int q = 0; q < 16; ++q) { const f4v v = *(const f4v*)(src + 4 * q); st[4 * q] = v.x; st[4 * q + 1] = v.y; st[4 * q + 2] = v.z; st[4 * q + 3] = v.w; } }
        scan_steps<false, true, true>(st, st, dir, b, h, c * CHL, CHL, RW + (size_t)RW_KK * RWA, RW + (size_t)(RW_W0 + dir) * RWA, RW + (size_t)(RW_B0 + dir) * RWA,
                                      RW + (size_t)(RW_KD0 + dir) * RWA, RW + (size_t)RW_V * RWA, RW + (size_t)RW_R * RWA, YS + (size_t)dir * RWA, lane);
    }
}

__device__ void finalize_phase(CArgs& a, int l) {
    unsigned char* ws = a.ws;
    const float* YS = (const float*)(ws + OFF_YS); const bf16_t* BON = (const bf16_t*)(ws + OFF_BON); const bf16_t* GG = (const bf16_t*)(ws + OFF_G);
    const float* PART = (const float*)(ws + OFF_PART); const float* PARTC = (const float*)(ws + OFF_PARTC); bf16_t* CC = (bf16_t*)(ws + OFF_CONCAT);
    const int ch = tid_opq() & 255;
    const float gng = a.in[I_GNG][l * 256 + ch], gnb = a.in[I_GNB][l * 256 + ch];
    for (int pr = bx_opq(); pr < MT / 2; pr += gridDim.x) {
        const int row = pr * 2 + (tid_opq() >> 8);
        const size_t o = (size_t)row * 256 + ch;
        const float y = YS[o] + YS[RWA + o];
        const float mean = wsum(y) * (1.0f / 64.0f), d = y - mean, var = wsum(d * d) * (1.0f / 64.0f);
        const float yn = d * rsqrtf(var + 64e-5f) * gng + gnb;
        CC[(size_t)row * DM + 256 + ch] = f2bf((yn + bf2f(BON[o])) * bf2f(GG[o]));
        float f;
        if (row < ML) { const int b = row >> 12, kt = row & 4095; const float* p = PART + (size_t)kt * 1024 + b * 256 + ch;
            f = (p[0] + p[(size_t)4096 * 1024]) + (p[(size_t)2 * 4096 * 1024] + p[(size_t)3 * 4096 * 1024]); }
        else { const int rr = row - ML, b = rr >> 8, kt = rr & 255; f = PARTC[(size_t)kt * 1024 + b * 256 + ch]; }
        CC[(size_t)row * DM + 768 + ch] = f2bf(f);
    }
}

__device__ void attn_phase(CArgs& a, int l, unsigned char* lds, int rep) {
    unsigned char* ws = a.ws;
    const bf16_t* Q = (const bf16_t*)(ws + OFF_Q); const bf16_t* QC = (const bf16_t*)(ws + OFF_QC); const bf16_t* Kb = (const bf16_t*)(ws + OFF_K); const bf16_t* VT = (const bf16_t*)(ws + OFF_VT);
    bf16_t* CC = (bf16_t*)(ws + OFF_CONCAT);
    unsigned* ctr = (unsigned*)(ws + OFF_CTL) + l + 8 * rep;
    bf16_t* Ks = (bf16_t*)lds;
    bf16_t* Vs = (bf16_t*)(lds + 64 * 72 * 2);
    volatile int* qslot = (volatile int*)(lds + 2 * 64 * 72 * 2);
    const int tid = tid_opq(), lane = tid & 63, wid = tid >> 6, lq = lane & 15, quad = lane >> 4;
    const int sr = tid >> 3, sc8 = (tid & 7) * 8;
    for (;;) {
        __syncthreads();
        if (tid == 0) *qslot = (int)atomicAdd(ctr, 1u);
        __syncthreads();
        const int u = *qslot;
        if (u >= 544) break;
        int b, hq, t0, nt, orow; const bf16_t* qp;
        if (u < 512) { b = u >> 7; hq = (u >> 5) & 3; t0 = (u & 31) * 128; nt = TK / 64; qp = Q + ((size_t)(b * 4 + hq) * SEQ + t0) * 64; orow = b * SEQ + t0; }
        else { const int uu = u - 512; b = uu >> 3; hq = (uu >> 1) & 3; t0 = (uu & 1) * 128; nt = CTXL / 64; qp = QC + ((size_t)(b * 4 + hq) * CTXL + t0) * 64; orow = ML + b * CTXL + t0; }
        const int kvh = hq >> 1;
        const bf16_t* kp = Kb + (size_t)(b * 2 + kvh) * TK * 64; const bf16_t* vp = VT + (size_t)(b * 2 + kvh) * 64 * TK;
        s16x8 qf[2];
#pragma unroll
        for (int ds = 0; ds < 2; ++ds) qf[ds] = *(const s16x8*)(qp + (size_t)(wid * 16 + lq) * 64 + ds * 32 + quad * 8);
        f4v o[4];
#pragma unroll
        for (int db = 0; db < 4; ++db) o[db] = (f4v){0.f, 0.f, 0.f, 0.f};
        float mrun = -1e30f, lrun = 0.f;
        u32x4v kreg = *(const u32x4v*)(kp + (size_t)sr * 64 + sc8), vreg = *(const u32x4v*)(vp + (size_t)sr * TK + sc8);
        for (int kt = 0; kt < nt; ++kt) {
            __syncthreads();
            *(u32x4v*)(Ks + sr * 72 + sc8) = kreg; *(u32x4v*)(Vs + sr * 72 + sc8) = vreg;
            __syncthreads();
            if (kt + 1 < nt) { kreg = *(const u32x4v*)(kp + (size_t)((kt + 1) * 64 + sr) * 64 + sc8); vreg = *(const u32x4v*)(vp + (size_t)sr * TK + (kt + 1) * 64 + sc8); }
            f4v s[4];
#pragma unroll
            for (int nb = 0; nb < 4; ++nb) {
                f4v acc = (f4v){0.f, 0.f, 0.f, 0.f};
#pragma unroll
                for (int ds = 0; ds < 2; ++ds) { const s16x8 kf = *(const s16x8*)(Ks + (nb * 16 + lq) * 72 + ds * 32 + quad * 8);
                    acc = __builtin_amdgcn_mfma_f32_16x16x32_bf16(kf, qf[ds], acc, 0, 0, 0); }
                s[nb] = acc;
            }
            float mx = fmaxf(fmaxf(s[0].x, s[0].y), fmaxf(s[0].z, s[0].w));
#pragma unroll
            for (int nb = 1; nb < 4; ++nb) mx = fmaxf(mx, fmaxf(fmaxf(s[nb].x, s[nb].y), fmaxf(s[nb].z, s[nb].w)));
            mx = fmaxf(mx, __shfl_xor(mx, 16)); mx = fmaxf(mx, __shfl_xor(mx, 32));
            const float mnew = fmaxf(mrun, mx), alpha = __builtin_amdgcn_exp2f(mrun - mnew); mrun = mnew;
            float ls = 0.f;
#pragma unroll
            for (int nb = 0; nb < 4; ++nb) { s[nb].x = __builtin_amdgcn_exp2f(s[nb].x - mnew); s[nb].y = __builtin_amdgcn_exp2f(s[nb].y - mnew);
                s[nb].z = __builtin_amdgcn_exp2f(s[nb].z - mnew); s[nb].w = __builtin_amdgcn_exp2f(s[nb].w - mnew); ls += (s[nb].x + s[nb].y) + (s[nb].z + s[nb].w); }
            lrun = lrun * alpha + ls;
#pragma unroll
            for (int db = 0; db < 4; ++db) o[db] *= alpha;
#pragma unroll
            for (int k2 = 0; k2 < 2; ++k2) {
                u32x4v pw; pw.x = cvt_pk_bf16(s[2 * k2].x, s[2 * k2].y); pw.y = cvt_pk_bf16(s[2 * k2].z, s[2 * k2].w);
                pw.z = cvt_pk_bf16(s[2 * k2 + 1].x, s[2 * k2 + 1].y); pw.w = cvt_pk_bf16(s[2 * k2 + 1].z, s[2 * k2 + 1].w);
                const s16x8 pf = __builtin_bit_cast(s16x8, pw);
#pragma unroll
                for (int db = 0; db < 4; ++db) {
                    const bf16_t* vr = Vs + (db * 16 + lq) * 72 + quad * 4;
                    const u32x2v v0 = *(const u32x2v*)(vr + (2 * k2) * 16), v1 = *(const u32x2v*)(vr + (2 * k2 + 1) * 16);
                    u32x4v vw; vw.x = v0.x; vw.y = v0.y; vw.z = v1.x; vw.w = v1.y;
                    o[db] = __builtin_amdgcn_mfma_f32_16x16x32_bf16(__builtin_bit_cast(s16x8, vw), pf, o[db], 0, 0, 0);
                }
            }
        }
        lrun += __shfl_xor(lrun, 16); lrun += __shfl_xor(lrun, 32);
        const float il = 1.0f / lrun;
        bf16_t* op = CC + (size_t)(orow + wid * 16 + lq) * DM + hq * 64 + quad * 4;
#pragma unroll
        for (int db = 0; db < 4; ++db) { u32x2v w; w.x = cvt_pk_bf16(o[db].x * il, o[db].y * il); w.y = cvt_pk_bf16(o[db].z * il, o[db].w * il); *(u32x2v*)(op + db * 16) = w; }
    }
}

#define XB_TMO      128
#define XB_XCNT(j)  (256  + 64 * (j))
#define XB_XSUB(j)  (1280 + 64 * (j))
#define XB_XGEN(j)  (2304 + 64 * (j))
#define XB_TOP      3328
#define XB_TOPGEN   3392
#define XCD_BAR_WORDS 3456
#define XB_SPIN_CAP (1u << 18)

__device__ __forceinline__ unsigned xb_ld(unsigned* p)              { return __hip_atomic_load(p, __ATOMIC_RELAXED, __HIP_MEMORY_SCOPE_AGENT); }
__device__ __forceinline__ unsigned xb_add(unsigned* p, unsigned v) { return __hip_atomic_fetch_add(p, v, __ATOMIC_RELAXED, __HIP_MEMORY_SCOPE_AGENT); }
__device__ __forceinline__ unsigned xb_xcc_id() { return (unsigned)__builtin_amdgcn_s_getreg((3 << 11) | 20) & 0xFu; }
#define XB_SPIN(cond, bar) do { unsigned _sp = 0; while (cond) { __builtin_amdgcn_s_sleep(1); \
    if ((++_sp & 255u) == 0u) { if (xb_ld(&(bar)[XB_TMO])) break; if (_sp > XB_SPIN_CAP) { atomicAdd(&(bar)[XB_TMO], 1u); break; } } } } while (0)

struct XcdBarrier {
    unsigned* bar; unsigned x;
    volatile LAS unsigned* st;
};

__device__ __forceinline__ XcdBarrier xcd_barrier_post(unsigned* bar, volatile LAS unsigned* st) {
    XcdBarrier b; b.bar = bar; b.x = xb_xcc_id(); b.st = st;
    if (threadIdx.x == 0) (void)xb_add(&bar[XB_XCNT(b.x)], 1u);
    return b;
}
__device__ __forceinline__ void xcd_barrier_complete(unsigned* bar, unsigned x, unsigned& nloc, unsigned& nx) {
    const unsigned G = gridDim.x * gridDim.y * gridDim.z;
    unsigned sum, cnt, mine, sp = 0u;
    for (;;) {
        sum = 0u; cnt = 0u; mine = 0u;
#pragma unroll
        for (unsigned j = 0; j < 16; ++j) { const unsigned c = xb_ld(&bar[XB_XCNT(j)]); sum += c; cnt += (c > 0u) ? 1u : 0u; mine = (j == x) ? c : mine; }
        if (sum == G) break;
        __builtin_amdgcn_s_sleep(1);
        if ((++sp & 255u) == 0u) { if (xb_ld(&bar[XB_TMO])) break; if (sp > XB_SPIN_CAP) { atomicAdd(&bar[XB_TMO], 1u); break; } }
    }
    nloc = mine > 0u ? mine : 1u; nx = cnt > 0u ? cnt : 1u;
}

__device__ __forceinline__ void xcd_barrier(const XcdBarrier& b) {
    asm volatile("s_waitcnt vmcnt(0)" ::: "memory");
    __syncthreads();
    if (threadIdx.x == 0) {
        unsigned* bar = b.bar;
        __builtin_amdgcn_s_waitcnt(0);
        unsigned nloc = b.st[0], nx = b.st[1];
        if (nloc == 0u) { xcd_barrier_complete(bar, b.x, nloc, nx); b.st[0] = nloc; b.st[1] = nx; }
        const unsigned old = xb_add(&bar[XB_XSUB(b.x)], 1u);
        const unsigned gen = old / nloc;
        if (old + 1u == (gen + 1u) * nloc) {
            __builtin_amdgcn_fence(__ATOMIC_RELEASE, "agent");
            asm volatile("s_waitcnt vmcnt(0)" ::: "memory");
            const unsigned og = xb_add(&bar[XB_TOP], 1u);
            const unsigned tg = og / nx;
            if (og + 1u == (tg + 1u) * nx) xb_add(&bar[XB_TOPGEN], 1u);
            else XB_SPIN(xb_ld(&bar[XB_TOPGEN]) == tg, bar);
            __builtin_amdgcn_fence(__ATOMIC_ACQUIRE, "agent");
            xb_add(&bar[XB_XGEN(b.x)], 1u);
            asm volatile("s_waitcnt vmcnt(0)" ::: "memory");
        } else {
            XB_SPIN(xb_ld(&bar[XB_XGEN(b.x)]) == gen, bar);
            __builtin_amdgcn_fence(__ATOMIC_ACQUIRE, "agent");
            asm volatile("s_waitcnt vmcnt(0)" ::: "memory");
        }
    }
    __syncthreads();
}

#define REP_GEMM 1
#define REP_PREP 1
#define REP_SCAN 1
#define REP_ATTN 1
#define REP_MISC 1
#define REP_PRO 1
#define REP_SYNC 1
#define REPEAT(n) for (int rep_ = 0; rep_ < (n); ++rep_)
__global__ void __launch_bounds__(512, 2) mega_fwd(Args a_unused) {
    extern __shared__ __attribute__((aligned(16))) unsigned char lds[];
    cg::grid_group grid = cg::this_grid();
    volatile LAS unsigned* bst = (volatile LAS unsigned*)((LAS unsigned char*)lds + 140000);
    if (tid_opq() == 0) { bst[0] = 0u; bst[1] = 0u; }
    __syncthreads();
    const XcdBarrier xbar = xcd_barrier_post((unsigned*)(KA.ws + OFF_CTL) + CTL_BAR, bst);
    float* sm = (float*)lds;
    PG8_LAS unsigned char* l3 = (PG8_LAS unsigned char*)lds;
    const int lo = KA.ph_lo, hi = KA.ph_hi;
#define G ((int)gridDim.x)
#define bx (bx_opq())
#define ws (KA.ws)
    int ph = 0;
#define PH_BEGIN if (ph >= lo && ph < hi) {
#define PH_END } ++ph; if (ph > lo && ph < hi) REPEAT(REP_SYNC) { if (ph == 1) grid.sync(); else xcd_barrier(xbar); }
#define H ((bf16_t*)(ws + OFF_H))
#define HID ((bf16_t*)(ws + OFF_HID))
#define Y ((float*)(ws + OFF_Y))

    PH_BEGIN REPEAT(REP_PRO) { prologue_a(KA, sm); } PH_END
    PH_BEGIN rowwise_phase(KA, 0, 0, 0, 0.f, 0, 0, false); PH_END
#pragma unroll 1
    for (int l = 0; l < DEPTH; ++l) {
#pragma unroll 1
        for (int f = 0; f < 2; ++f) {
            if (f == 1) {
                PH_BEGIN REPEAT(REP_GEMM) { pg8::Gemm g{H, (const bf16_t*)(ws + OFF_WIN) + (size_t)l * NIN * 1024, 1024, 1024, 1024}; pg8::StaticOrder S; S.init(MT, NIN, 1, G, bx);
                    pg8::EpiWin E{(bf16_t*)(ws + OFF_Z), (bf16_t*)(ws + OFF_ZT), (bf16_t*)(ws + OFF_ZTC), (bf16_t*)(ws + OFF_PB)};
                    pg8::gemm_phase<pg8::EpiWin, pg8::StaticOrder, true, true>(l3, g, S, E); } PH_END
                PH_BEGIN REPEAT(REP_PREP) { attn_prep(KA, l, sm); pool_prep(KA); rwkv_prep(KA, l, sm); } PH_END
                PH_BEGIN REPEAT(REP_SCAN) { scan_pass1(KA); } __syncthreads(); REPEAT(REP_GEMM) {
                    { pg8::Gemm g{(const bf16_t*)(ws + OFF_DFT), (const bf16_t*)(ws + OFF_ZT), 8192, 8192, 2048}; pg8::StaticOrder S; S.init(SEQ, 1024, 4, G, bx);
                      pg8::EpiF32 E{(float*)(ws + OFF_PART), 1024, (size_t)SEQ * 1024};
                      pg8::gemm_phase<pg8::EpiF32, pg8::StaticOrder, true, true>(l3, g, S, E); }
                    { pg8::Gemm g{(const bf16_t*)(ws + OFF_DFTC), (const bf16_t*)(ws + OFF_ZTC), 512, 512, 512}; pg8::StaticOrder S; S.init(CTXL, 1024, 1, G, bx);
                      pg8::EpiF32 E{(float*)(ws + OFF_PARTC), 1024, 0};
                      pg8::gemm_phase<pg8::EpiF32, pg8::StaticOrder, true, true>(l3, g, S, E); } } PH_END
                PH_BEGIN REPEAT(REP_MISC) { scan_pass2(KA, sm); } REPEAT(REP_ATTN) { attn_phase(KA, l, lds, rep_); } PH_END
                PH_BEGIN REPEAT(REP_SCAN) { scan_pass3(KA); } PH_END
                PH_BEGIN REPEAT(REP_MISC) { finalize_phase(KA, l); } PH_END
                PH_BEGIN REPEAT(REP_GEMM) { pg8::Gemm g{(const bf16_t*)(ws + OFF_CONCAT), (const bf16_t*)(ws + OFF_WOUT) + (size_t)l * 1024 * 1024, 1024, 1024, 1024}; pg8::StaticOrder S; S.init(MT, 1024, 1, G, bx);
                    pg8::EpiF32 E{Y, 1024, 0};
                    pg8::gemm_phase<pg8::EpiF32, pg8::StaticOrder, true, true>(l3, g, S, E); } PH_END
                PH_BEGIN rowwise_phase(KA, 1, l, 1, 1.0f, l, 2, false); PH_END
            }
            PH_BEGIN REPEAT(REP_GEMM) { pg8::Gemm g{H, (const bf16_t*)(ws + OFF_WGU) + (size_t)(l * 2 + f) * 5632 * 1024, 1024, 1024, 1024}; pg8::StaticOrder S; S.init(MT, 5632, 1, G, bx);
                pg8::EpiSwiglu E{HID, DFF};
                pg8::gemm_phase<pg8::EpiSwiglu, pg8::StaticOrder, true, true>(l3, g, S, E); } PH_END
            PH_BEGIN REPEAT(REP_GEMM) { pg8::Gemm g{HID, (const bf16_t*)(ws + OFF_WDN) + (size_t)(l * 2 + f) * 1024 * 2816, 2816, 2816, 2816}; pg8::StaticOrder S; S.init(MT, 1024, 1, G, bx);
                pg8::EpiF32 E{Y, 1024, 0};
                pg8::gemm_phase<pg8::EpiF32, pg8::StaticOrder, true, true>(l3, g, S, E); } PH_END
            PH_BEGIN if (f == 0) rowwise_phase(KA, 1, l, 0, 0.5f, l, 1, false);
                     else rowwise_phase(KA, 1, l, 2, 0.5f, l + 1 < DEPTH ? l + 1 : -1, 0, l + 1 == DEPTH); PH_END
        }
    }
#undef PH_BEGIN
#undef PH_END
#undef G
#undef bx
#undef ws
#undef H
#undef HID
#undef Y
}

constexpr int N_PHASES = 2 + DEPTH * 14;
#ifndef MK_PER_PHASE
#define MK_PER_PHASE 0
#endif

extern "C" void kernel_launch(void* const* d_in, const int* in_sizes, int n_in, void* d_out, int out_size, void* d_ws, size_t ws_size, hipStream_t stream) {
    static int grid = 0;
    if (grid == 0) {
        if (n_in != 31 || ws_size < WS_END) { fprintf(stderr, "kernel_launch: need 31 inputs and %zu bytes of workspace (got %d, %zu)\n", (size_t)WS_END, n_in, ws_size); grid = -1; return; }
        int dev = 0, cus = 0, per_cu = 0;
        hipGetDevice(&dev); hipDeviceGetAttribute(&cus, hipDeviceAttributeMultiprocessorCount, dev);
        if (hipFuncSetAttribute((const void*)mega_fwd, hipFuncAttributeMaxDynamicSharedMemorySize, LDS_BYTES) != hipSuccess) { fprintf(stderr, "kernel_launch: hipFuncSetAttribute failed\n"); grid = -1; return; }
        hipOccupancyMaxActiveBlocksPerMultiprocessor(&per_cu, (const void*)mega_fwd, 512, LDS_BYTES);
        (void)hipGetLastError();
        if (per_cu < 1) fprintf(stderr, "kernel_launch: occupancy query says %d blocks per CU\n", per_cu);
        grid = cus > 0 ? cus : 256;
    }
    if (grid < 0) return;
    if (hipMemsetAsync((char*)d_ws + OFF_CTL, 0, CTL_ZERO_BYTES, stream) != hipSuccess) { fprintf(stderr, "kernel_launch: memset of the control words failed\n"); return; }
    Args a{};
    for (int i = 0; i < 31; ++i) a.in[i] = (const float*)d_in[i];
    a.out = (float*)d_out; a.ws = (unsigned char*)d_ws;
#if MK_PER_PHASE
    for (int p = 0; p < N_PHASES; ++p) { a.ph_lo = p; a.ph_hi = p + 1; void* args[] = {&a};
        hipError_t e = hipLaunchCooperativeKernel((const void*)mega_fwd, dim3(grid), dim3(512), args, LDS_BYTES, stream);
        if (e != hipSuccess) { fprintf(stderr, "launch %d failed: %s\n", p, hipGetErrorString(e)); break; } }
#else
    a.ph_lo = 0; a.ph_hi = N_PHASES;
    void* args[] = {&a};
    hipError_t e = hipLaunchCooperativeKernel((const void*)mega_fwd, dim3(grid), dim3(512), args, LDS_BYTES, stream);
    if (e != hipSuccess) fprintf(stderr, "cooperative launch failed: %s (grid %d)\n", hipGetErrorString(e), grid);
#endif
}
```

```cpp
#include <hip/hip_runtime.h>
#include <hip/hip_cooperative_groups.h>
#include <cstdio>
#include <cstdint>
namespace cg = cooperative_groups;

__device__ __forceinline__ int tid_opq() { int t = threadIdx.x; asm volatile("" : "+v"(t)); return t; }
__device__ __forceinline__ int bx_opq() { int t = blockIdx.x; asm volatile("" : "+s"(t)); return t; }
namespace pg8 {
#define PG8_LAS __attribute__((address_space(3)))
typedef unsigned short bf16_t;
typedef short bf16x8 __attribute__((ext_vector_type(8)));
typedef float f32x4 __attribute__((ext_vector_type(4)));
typedef unsigned u32x4 __attribute__((ext_vector_type(4)));
constexpr int BM = 256, BK = 64, HALF = 128, HTB = HALF * BK * 2, STAGE_BYTES = 8 * HTB, NXCD = 8, WGM = 8;

__host__ __device__ __forceinline__ int lds_byte(int r, int c) { const int st = (r >> 4) * 2 + (c >> 5), rr = r & 15, cc = c & 31, ob = rr * 64 + cc * 2; return st * 1024 + (ob ^ (((ob >> 9) & 1) << 5)); }
__host__ __device__ __forceinline__ void stage_rc(int b, int& R, int& C) { const int st = b / 1024, sb = b % 1024, swz = sb ^ (((sb >> 9) & 1) << 5); R = (st >> 1) * 16 + swz / 64; C = (st & 1) * 32 + (swz % 64) / 2; }
__host__ __device__ __forceinline__ int perm32(int rho) { const int n = rho >> 4, i = rho & 15; return 8 * (i >> 2) + 4 * n + (i & 3); }

struct Unit { int pm, pn, ks; };
struct Gemm { const bf16_t* A; const bf16_t* Bt; int lda, ldb, K; };

struct StaticOrder {
    int nM, nN, nNS, nwg, G, c;
    __device__ void init(int M, int N, int nS, int G_, int c_) { nM = M / BM; nN = N / BM; nNS = nN * nS; nwg = nM * nNS; G = G_; c = c_; }
    __device__ bool next(int i, Unit& u) const {
        const long L = (long)i * G + c; if (L >= nwg) return false;
        int wgid = (int)L; { const int q = nwg / NXCD, r = nwg % NXCD, xcd = wgid % NXCD, off = wgid / NXCD; wgid = (xcd < r ? xcd * (q + 1) : r * (q + 1) + (xcd - r) * q) + off; }
        const int nig = WGM * nNS, gid = wgid / nig, fm = gid * WGM, gsz = (nM - fm) < WGM ? (nM - fm) : WGM;
        u.pm = fm + ((wgid % nig) % gsz); const int pc = (wgid % nig) / gsz; u.pn = pc % nN; u.ks = pc / nN; return true;
    }
    __device__ __forceinline__ void a_ready(const Unit&) const {}
    __device__ __forceinline__ void done(const Unit&) const {}
};

__device__ __forceinline__ unsigned cvt_pk_bf16(float lo, float hi) { unsigned r; asm volatile("v_cvt_pk_bf16_f32 %0, %1, %2" : "=v"(r) : "v"(lo), "v"(hi)); return r; }
__device__ __forceinline__ float silu_f(float x) { return x * __builtin_amdgcn_rcpf(1.0f + __builtin_amdgcn_exp2f(-1.4426950408889634f * x)); }

struct EpiSwiglu {
    static constexpr bool PERM = true, AFTER_DRAIN = false;
    bf16_t* O; int ldc;
    __device__ __forceinline__ void operator()(const f32x4 (&acc)[2][2][4][2], const Unit& u, int wr, int wc, int fr, int fq) const {
        const int row0 = u.pm * BM + wr * 64 + fr, col0 = u.pn * HALF + wc * 32 + 8 * fq;
#pragma unroll
        for (int ai = 0; ai < 2; ++ai)
#pragma unroll
            for (int m = 0; m < 4; ++m) {
                bf16_t* rowp = O + (size_t)(row0 + ai * HALF + m * 16) * ldc + col0;
                const f32x4 g0 = acc[ai][0][m][0], g1 = acc[ai][0][m][1], u0 = acc[ai][1][m][0], u1 = acc[ai][1][m][1];
                u32x4 w;
                w.x = cvt_pk_bf16(silu_f(g0[0]) * u0[0], silu_f(g0[1]) * u0[1]); w.y = cvt_pk_bf16(silu_f(g0[2]) * u0[2], silu_f(g0[3]) * u0[3]);
                w.z = cvt_pk_bf16(silu_f(g1[0]) * u1[0], silu_f(g1[1]) * u1[1]); w.w = cvt_pk_bf16(silu_f(g1[2]) * u1[2], silu_f(g1[3]) * u1[3]);
                *(u32x4*)rowp = w;
            }
    }
};
struct EpiF32 {
    static constexpr bool PERM = false, AFTER_DRAIN = false;
    float* O; int ldc; size_t sstride;
    __device__ __forceinline__ void operator()(const f32x4 (&acc)[2][2][4][2], const Unit& u, int wr, int wc, int fr, int fq) const {
        const int row0 = u.pm * BM + wr * 64 + fr, col0 = u.pn * BM + wc * 32 + 4 * fq;
        float* base = O + (size_t)u.ks * sstride;
#pragma unroll
        for (int ai = 0; ai < 2; ++ai)
#pragma unroll
            for (int m = 0; m < 4; ++m) {
                float* rowp = base + (size_t)(row0 + ai * HALF + m * 16) * ldc + col0;
#pragma unroll
                for (int bj = 0; bj < 2; ++bj)
#pragma unroll
                    for (int n = 0; n < 2; ++n) *(f32x4*)(rowp + bj * HALF + n * 16) = acc[ai][bj][m][n];
            }
    }
};
struct EpiWin {
    static constexpr bool PERM = true, AFTER_DRAIN = false;
    bf16_t* Z; bf16_t* ZT; bf16_t* ZTC; bf16_t* PB;
    __device__ __forceinline__ void operator()(const f32x4 (&acc)[2][2][4][2], const Unit& u, int wr, int wc, int fr, int fq) const {
        const int row0 = u.pm * BM + wr * 64 + fr;
        if (u.pn < 7 || u.pn >= 9) {
            const bool isz = u.pn < 7;
            const int col0 = (isz ? u.pn : u.pn - 9) * BM + wc * 32 + 8 * fq; const int ldz = isz ? 1792 : 512; bf16_t* ob = isz ? Z : PB;
#pragma unroll
            for (int ai = 0; ai < 2; ++ai)
#pragma unroll
                for (int m = 0; m < 4; ++m) {
                    bf16_t* rowp = ob + (size_t)(row0 + ai * HALF + m * 16) * ldz + col0;
#pragma unroll
                    for (int bj = 0; bj < 2; ++bj) { const f32x4 v0 = acc[ai][bj][m][0], v1 = acc[ai][bj][m][1]; u32x4 w;
                        w.x = cvt_pk_bf16(v0[0], v0[1]); w.y = cvt_pk_bf16(v0[2], v0[3]); w.z = cvt_pk_bf16(v1[0], v1[1]); w.w = cvt_pk_bf16(v1[2], v1[3]);
                        *(u32x4*)(rowp + bj * HALF) = w; }
                }
        } else {
            const int part = u.pn - 7;
#pragma unroll
            for (int ai = 0; ai < 2; ++ai)
#pragma unroll
                for (int m = 0; m < 4; ++m) {
                    const int row = row0 + ai * HALF + m * 16;
                    bf16_t* base; size_t ld;
                    if (row < 16384) { const int b = row >> 12, t = row & 4095; base = ZT + (size_t)(b * 256) * 8192 + part * 4096 + t; ld = 8192; }
                    else { const int rr = row - 16384, b = rr >> 8, j = rr & 255; base = ZTC + (size_t)(b * 256) * 512 + part * 256 + j; ld = 512; }
#pragma unroll
                    for (int bj = 0; bj < 2; ++bj)
#pragma unroll
                        for (int n = 0; n < 2; ++n) { const f32x4 v = acc[ai][bj][m][n]; const int ch = bj * HALF + wc * 32 + 8 * fq + 4 * n;
                            const unsigned p0 = cvt_pk_bf16(v[0], v[1]), p1 = cvt_pk_bf16(v[2], v[3]);
                            base[(size_t)(ch + 0) * ld] = (bf16_t)(p0 & 0xffffu); base[(size_t)(ch + 1) * ld] = (bf16_t)(p0 >> 16);
                            base[(size_t)(ch + 2) * ld] = (bf16_t)(p1 & 0xffffu); base[(size_t)(ch + 3) * ld] = (bf16_t)(p1 >> 16); }
                }
        }
    }
};

template <class Epi, class Sched, bool ALIGN_EPI = false, bool SP2 = false>
__device__ __forceinline__ void gemm_phase(PG8_LAS unsigned char* lds, const Gemm g, const Sched& S, const Epi& E) {
    const int tid = tid_opq(), wid = __builtin_amdgcn_readfirstlane(tid >> 6), lane = tid & 63, wr = wid >> 2, wc = wid & 3, fr = lane & 15, fq = lane >> 4;
    const int K = g.K, nt = K / BK;
    unsigned voffA[2], voffB[2];
#pragma unroll
    for (int i = 0; i < 2; ++i) { int R, C; stage_rc(tid * 16 + i * 8192, R, C); const int Rb = Epi::PERM ? ((R & ~31) + perm32(R & 31)) : R;
        voffA[i] = (unsigned)(R * g.lda + C) * 2u; voffB[i] = (unsigned)(Rb * g.ldb + C) * 2u; }
    const size_t kstep = (size_t)(BK * 2);
    const size_t hstepA = (size_t)HALF * g.lda * 2, hstepB = (size_t)HALF * g.ldb * 2;
    const size_t tstepA = 2 * hstepA, tstepB = 2 * hstepB, ksb = (size_t)K * 2;
    const unsigned ldsw = (unsigned)wid * 1024u;
    const int aoff = lds_byte(wr * 64 + fr, fq * 8), boff = lds_byte(wc * 32 + fr, fq * 8);
#define PG8_SA(b, h) (((b) * 2 + (h)) * HTB)
#define PG8_SB(b, h) ((4 + (b) * 2 + (h)) * HTB)
#define PG8_STAGE(bufoff, gbase, voff) do { _Pragma("unroll") for (int _i = 0; _i < 2; ++_i) \
        __builtin_amdgcn_global_load_lds((const unsigned*)((const char*)(gbase) + (voff)[_i]), (PG8_LAS unsigned*)(lds + (bufoff) + ldsw + _i * 8192), 16, 0, 0); } while (0)
#define PG8_LDA(dst, b, h) do { _Pragma("unroll") for (int m = 0; m < 4; ++m) _Pragma("unroll") for (int k = 0; k < 2; ++k) dst[m][k] = *(const PG8_LAS bf16x8*)(lds + PG8_SA(b, h) + aoff + m * 2048 + k * 1024); } while (0)
#define PG8_LDB(dst, b, h) do { _Pragma("unroll") for (int n = 0; n < 2; ++n) _Pragma("unroll") for (int k = 0; k < 2; ++k) dst[n][k] = *(const PG8_LAS bf16x8*)(lds + PG8_SB(b, h) + boff + n * 2048 + k * 1024); } while (0)
#define PG8_MMA(ai, bj, At, Bt) do { __builtin_amdgcn_s_setprio(1); _Pragma("unroll") for (int m = 0; m < 4; ++m) _Pragma("unroll") for (int n = 0; n < 2; ++n) _Pragma("unroll") for (int k = 0; k < 2; ++k) \
        acc[ai][bj][m][n] = __builtin_amdgcn_mfma_f32_16x16x32_bf16(Bt[n][k], At[m][k], acc[ai][bj][m][n], 0, 0, 0); __builtin_amdgcn_s_setprio(0); } while (0)
#define PG8_WAIT_V(n) asm volatile("s_waitcnt vmcnt(" #n ")" ::: "memory")
#define PG8_WAIT_L(n) asm volatile("s_waitcnt lgkmcnt(" #n ")" ::: "memory")
#define PG8_BAR __builtin_amdgcn_s_barrier()
#define PG8_SCHED __builtin_amdgcn_sched_barrier(0)
    Unit cur, nxt; int ui = 0;
    if (!S.next(0, cur)) return;
    f32x4 acc[2][2][4][2];
#pragma unroll
    for (int a = 0; a < 2; ++a)
#pragma unroll
        for (int b = 0; b < 2; ++b)
#pragma unroll
            for (int m = 0; m < 4; ++m)
#pragma unroll
                for (int n = 0; n < 2; ++n) acc[a][b][m][n] = (f32x4){0.f, 0.f, 0.f, 0.f};
    bf16x8 At[4][2], B0[2][2], B1[2][2];
    const char* cA = (const char*)g.A + (size_t)cur.pm * tstepA + (size_t)cur.ks * ksb; const char* cB = (const char*)g.Bt + (size_t)cur.pn * tstepB + (size_t)cur.ks * ksb;
    S.a_ready(cur);
    if constexpr (SP2) {
        PG8_STAGE(PG8_SB(0, 0), cB, voffB); PG8_STAGE(PG8_SB(0, 1), cB + hstepB, voffB); PG8_STAGE(PG8_SA(0, 0), cA, voffA); PG8_STAGE(PG8_SA(0, 1), cA + hstepA, voffA);
        if (wr == 1) PG8_BAR;
        PG8_WAIT_V(2); PG8_BAR;
        PG8_STAGE(PG8_SB(1, 0), cB + kstep, voffB); PG8_STAGE(PG8_SA(1, 0), cA + kstep, voffA); PG8_STAGE(PG8_SB(1, 1), cB + hstepB + kstep, voffB);
        PG8_WAIT_V(6); PG8_BAR;
    } else {
        PG8_STAGE(PG8_SB(0, 0), cB, voffB); PG8_STAGE(PG8_SA(0, 0), cA, voffA); PG8_STAGE(PG8_SB(0, 1), cB + hstepB, voffB); PG8_STAGE(PG8_SA(0, 1), cA + hstepA, voffA);
        if (wr == 1) PG8_BAR;
        PG8_WAIT_V(4); PG8_BAR;
        PG8_STAGE(PG8_SB(1, 0), cB + kstep, voffB); PG8_STAGE(PG8_SA(1, 0), cA + kstep, voffA); PG8_STAGE(PG8_SB(1, 1), cB + hstepB + kstep, voffB);
        PG8_WAIT_V(6); PG8_BAR;
    }
    for (;;) {
        const bool has_next = S.next(ui + 1, nxt);
        const char* nA = has_next ? (const char*)g.A + (size_t)nxt.pm * tstepA + (size_t)nxt.ks * ksb : cA; const char* nB = has_next ? (const char*)g.Bt + (size_t)nxt.pn * tstepB + (size_t)nxt.ks * ksb : cB;
        for (int t = 0; t < nt; t += 2) {
            const bool last = (t == nt - 2);
            const char* a1 = cA + (size_t)(t + 1) * kstep;
            const char* a2 = last ? nA : cA + (size_t)(t + 2) * kstep; const char* b2 = last ? nB : cB + (size_t)(t + 2) * kstep;
            const char* a3 = a2 + kstep; const char* b3 = b2 + kstep;
            if (last && has_next) S.a_ready(nxt);
            if constexpr (SP2) {
            PG8_LDB(B0, 0, 0); PG8_LDB(B1, 0, 1); PG8_SCHED; PG8_LDA(At, 0, 0); PG8_STAGE(PG8_SA(1, 1), a1 + hstepA, voffA);
            PG8_WAIT_V(8); PG8_WAIT_L(0); PG8_BAR; PG8_MMA(0, 0, At, B0); PG8_MMA(0, 1, At, B1); PG8_BAR; PG8_SCHED;
            PG8_LDA(At, 0, 1); PG8_STAGE(PG8_SB(0, 0), b2, voffB); PG8_STAGE(PG8_SB(0, 1), b2 + hstepB, voffB); PG8_STAGE(PG8_SA(0, 0), a2, voffA);
            PG8_WAIT_V(8); PG8_WAIT_L(0); PG8_BAR; PG8_MMA(1, 0, At, B0); PG8_MMA(1, 1, At, B1); PG8_BAR; PG8_SCHED;
            PG8_LDB(B0, 1, 0); PG8_LDB(B1, 1, 1); PG8_SCHED; PG8_LDA(At, 1, 0); PG8_STAGE(PG8_SA(0, 1), a2 + hstepA, voffA);
            PG8_WAIT_V(8); PG8_WAIT_L(0); PG8_BAR; PG8_MMA(0, 0, At, B0); PG8_MMA(0, 1, At, B1); PG8_BAR; PG8_SCHED;
            PG8_LDA(At, 1, 1); PG8_STAGE(PG8_SB(1, 0), b3, voffB); PG8_STAGE(PG8_SB(1, 1), b3 + hstepB, voffB); PG8_STAGE(PG8_SA(1, 0), a3, voffA);
            PG8_WAIT_V(8); PG8_WAIT_L(0); PG8_BAR; PG8_MMA(1, 0, At, B0); PG8_MMA(1, 1, At, B1); PG8_BAR; PG8_SCHED;
            } else {
            PG8_LDB(B0, 0, 0); PG8_SCHED; PG8_LDA(At, 0, 0); PG8_STAGE(PG8_SA(1, 1), a1 + hstepA, voffA);
            PG8_WAIT_L(8); PG8_BAR; PG8_WAIT_L(0); PG8_MMA(0, 0, At, B0); PG8_BAR; PG8_SCHED;
            PG8_LDB(B1, 0, 1); PG8_STAGE(PG8_SB(0, 0), b2, voffB);
            PG8_BAR; PG8_WAIT_L(0); PG8_MMA(0, 1, At, B1); PG8_BAR;
            PG8_LDA(At, 0, 1); PG8_STAGE(PG8_SA(0, 0), a2, voffA);
            PG8_BAR; PG8_WAIT_L(0); PG8_MMA(1, 0, At, B0); PG8_BAR; PG8_SCHED;
            PG8_STAGE(PG8_SB(0, 1), b2 + hstepB, voffB);
            PG8_WAIT_V(6); PG8_BAR; PG8_MMA(1, 1, At, B1); PG8_BAR;
            PG8_LDB(B0, 1, 0); PG8_SCHED; PG8_LDA(At, 1, 0); PG8_STAGE(PG8_SA(0, 1), a2 + hstepA, voffA);
            PG8_WAIT_L(8); PG8_BAR; PG8_WAIT_L(0); PG8_MMA(0, 0, At, B0); PG8_BAR; PG8_SCHED;
            PG8_LDB(B1, 1, 1); PG8_STAGE(PG8_SB(1, 0), b3, voffB);
            PG8_BAR; PG8_WAIT_L(0); PG8_MMA(0, 1, At, B1); PG8_BAR;
            PG8_LDA(At, 1, 1); PG8_STAGE(PG8_SA(1, 0), a3, voffA);
            PG8_BAR; PG8_WAIT_L(0); PG8_MMA(1, 0, At, B0); PG8_BAR; PG8_SCHED;
            PG8_STAGE(PG8_SB(1, 1), b3 + hstepB, voffB);
            PG8_WAIT_V(6); PG8_BAR; PG8_MMA(1, 1, At, B1); PG8_BAR;
            }
        }
        if constexpr (ALIGN_EPI) { if (wr == 0) PG8_BAR; }
        if constexpr (!Epi::AFTER_DRAIN) { E(acc, cur, wr, wc, fr, fq); S.done(cur); }
        if (!has_next) break;
#pragma unroll
        for (int a = 0; a < 2; ++a)
#pragma unroll
            for (int b = 0; b < 2; ++b)
#pragma unroll
                for (int m = 0; m < 4; ++m)
#pragma unroll
                    for (int n = 0; n < 2; ++n) acc[a][b][m][n] = (f32x4){0.f, 0.f, 0.f, 0.f};
        cur = nxt; cA = nA; cB = nB; ++ui;
        if constexpr (ALIGN_EPI) { if (wr == 1) PG8_BAR; }
    }
    PG8_WAIT_V(0);
    if constexpr (!ALIGN_EPI) { if (wr == 0) PG8_BAR; }
    PG8_BAR;
    if constexpr (Epi::AFTER_DRAIN) { E.fused(acc, cur, wr, wc, fr, fq, lds, wid, lane); S.done(cur); }
#undef PG8_SA
#undef PG8_SB
#undef PG8_STAGE
#undef PG8_LDA
#undef PG8_LDB
#undef PG8_MMA
#undef PG8_WAIT_V
#undef PG8_WAIT_L
#undef PG8_BAR
#undef PG8_SCHED
}
}

using pg8::bf16_t;
using pg8::cvt_pk_bf16;
typedef float f4v __attribute__((ext_vector_type(4)));
typedef short s16x8 __attribute__((ext_vector_type(8)));
typedef short s16x4 __attribute__((ext_vector_type(4)));
typedef unsigned u32x4v __attribute__((ext_vector_type(4)));
typedef unsigned u32x2v __attribute__((ext_vector_type(2)));
#define LAS __attribute__((address_space(3)))

constexpr int DM = 1024, NBAT = 4, SEQ = 4096, DEPTH = 4, CTXL = 256, DFF = 2816;
constexpr int ML = NBAT * SEQ, MC = NBAT * CTXL, MT = ML + MC;
constexpr int NIN = 2816, ZW = 1792, TK = SEQ + CTXL;
constexpr int NCH = 32, CHL = TK / NCH;
constexpr float ALPHA = 1.681792830507429f;
constexpr float QSCALE = 0.125f * 1.4426950408889634f;

constexpr size_t MiB = 1u << 20;
constexpr size_t OFF_CTL = 0, OFF_MOD = 1 * MiB, OFF_WGU = 2 * MiB, OFF_WDN = 90 * MiB, OFF_WIN = 134 * MiB, OFF_WOUT = 156 * MiB,
                 OFF_DFT = 164 * MiB, OFF_DFTC = 228 * MiB, OFF_X = 229 * MiB, OFF_H = 297 * MiB, OFF_Y = 331 * MiB, OFF_HID = 399 * MiB,
                 OFF_Z = 399 * MiB, OFF_ZT = 459 * MiB, OFF_ZTC = 475 * MiB, OFF_Q = 476 * MiB, OFF_QC = 484 * MiB, OFF_K = 485 * MiB, OFF_VT = 490 * MiB,
                 OFF_RW = 495 * MiB, OFF_BON = 648 * MiB, OFF_G = 657 * MiB, OFF_PST = 666 * MiB, OFF_UST = 682 * MiB, WS_END = 698 * MiB;
constexpr size_t OFF_CONCAT = OFF_H, OFF_PART = OFF_Y, OFF_PARTC = OFF_Y + 64 * MiB, OFF_YS = OFF_Z, OFF_SST = OFF_ZT;
constexpr size_t OFF_PB = OFF_Y;
static_assert((size_t)32 * NCH * 4096 * 4 <= 16 * MiB, "chunk-state buffers are 16 MiB each");
constexpr int CTL_BAR = 4096;
constexpr size_t CTL_ZERO_BYTES = 65536;
constexpr size_t RWA = (size_t)MT * 256;
enum { RW_R = 0, RW_V, RW_KK, RW_W0, RW_W1, RW_KD0, RW_KD1, RW_B0, RW_B1 };
constexpr int LDS_BYTES = 147456;

struct Args { const float* in[31]; float* out; unsigned char* ws; int ph_lo, ph_hi; };
typedef const Args __attribute__((address_space(4))) CArgs;
__device__ __forceinline__ CArgs* kargs() { unsigned long long v = (unsigned long long)__builtin_amdgcn_kernarg_segment_ptr(); asm volatile("" : "+s"(v)); return (CArgs*)v; }
#define KA (*kargs())
enum { I_X = 0, I_C, I_CTX, I_CCTX, I_WMOD, I_BMOD, I_LNG, I_LNB, I_WFI, I_WFO, I_WIN, I_QG, I_KG, I_MU, I_DW0, I_DW1, I_DW2, I_IA0, I_IA1, I_IA2, I_GG1, I_GG2,
       I_KK, I_KA, I_RK, I_GNG, I_GNB, I_PW, I_PS, I_FW, I_WOUT };

__device__ __forceinline__ float bf2f(bf16_t u) { return __uint_as_float((unsigned)u << 16); }
__device__ __forceinline__ bf16_t f2bf(float f) { const unsigned u = __float_as_uint(f); return (bf16_t)((u + 0x7fffu + ((u >> 16) & 1u)) >> 16); }
__device__ __forceinline__ float wsum(float v) {
#pragma unroll
    for (int o = 32; o; o >>= 1) v += __shfl_xor(v, o);
    return v;
}
__device__ __forceinline__ float sigm(float x) { return __builtin_amdgcn_rcpf(1.0f + __builtin_amdgcn_exp2f(-1.4426950408889634f * x)); }
__device__ __forceinline__ float tanh_fast(float x) { const float xc = fminf(fmaxf(x, -15.f), 15.f); return 1.0f - 2.0f * __builtin_amdgcn_rcpf(1.0f + __builtin_amdgcn_exp2f(2.8853900817779268f * xc)); }

__device__ __forceinline__ void tcvt_tile(const float* __restrict__ src, int src_ld, int k0, int c0, bf16_t* __restrict__ dst, int dst_ld, int n0, float* tile) {
    const int tid = tid_opq();
#pragma unroll
    for (int i = 0; i < 8; ++i) { const int k = i * 8 + (tid >> 6), n = tid & 63; tile[k * 65 + n] = src[(size_t)(k0 + k) * src_ld + c0 + n]; }
    __syncthreads();
#pragma unroll
    for (int i = 0; i < 4; ++i) { const int n = i * 16 + (tid >> 5), k = (tid & 31) * 2;
        *(unsigned*)(dst + (size_t)(n0 + n) * dst_ld + k0 + k) = cvt_pk_bf16(tile[k * 65 + n], tile[(k + 1) * 65 + n]); }
    __syncthreads();
}

__device__ void prologue_a(CArgs& a, float* sm) {
    unsigned char* ws = a.ws;
    const int tid = tid_opq(), G = gridDim.x, bx = bx_opq();
    bf16_t* WGU = (bf16_t*)(ws + OFF_WGU); bf16_t* WDN = (bf16_t*)(ws + OFF_WDN); bf16_t* WIN = (bf16_t*)(ws + OFF_WIN); bf16_t* WOUT = (bf16_t*)(ws + OFF_WOUT);
    if (bx == 0 && tid < 64) ((unsigned*)(ws + OFF_CTL))[tid] = 0u;
    float* tile = sm;
    for (int j = bx; j < 19200; j += G) {
        if (j < 11264) { const int mat = j / 1408, r = j % 1408, kt = r / 88, nt = r % 88, n0 = nt * 64, pn = n0 >> 8, bj = (n0 >> 7) & 1, i0 = n0 & 127;
            tcvt_tile(a.in[I_WFI] + (size_t)mat * 1024 * 5632, 5632, kt * 64, bj * 2816 + pn * 128 + i0, WGU + (size_t)mat * 5632 * 1024, 1024, n0, tile); }
        else if (j < 16896) { const int jj = j - 11264, mat = jj / 704, r = jj % 704, kt = r / 16, nt = r % 16;
            tcvt_tile(a.in[I_WFO] + (size_t)mat * 2816 * 1024, 1024, kt * 64, nt * 64, WDN + (size_t)mat * 1024 * 2816, 2816, nt * 64, tile); }
        else if (j < 18688) { const int jj = j - 16896, l = jj / 448, r = jj % 448, kt = r / 28, nt = r % 28;
            tcvt_tile(a.in[I_WIN] + (size_t)l * 1024 * 2048, 2048, kt * 64, nt * 64, WIN + (size_t)l * NIN * 1024, 1024, nt * 64, tile); }
        else { const int jj = j - 18688, l = jj / 128, r = jj % 128, kt = r / 16, nt = r % 16;
            tcvt_tile(a.in[I_WOUT] + (size_t)l * 1024 * 1024, 1024, kt * 64, nt * 64, WOUT + (size_t)l * 1024 * 1024, 1024, nt * 64, tile); }
    }
    float* tab = sm;
    float* sc = sm + 4096;
    for (int m = tid; m < 4096; m += 512) tab[m] = cospif((float)m * (1.0f / 2048.0f));
    for (int i = tid; i < 5 * 1024; i += 512) { const float v = i < 4096 ? a.in[I_C][i] : a.in[I_CCTX][i - 4096]; sc[i] = v * sigm(v); }
    __syncthreads();
    const size_t gt = (size_t)bx * 512 + tid, gn = (size_t)G * 512;
    for (size_t idx = gt; idx < (size_t)4 * 1024 * 512; idx += gn) {
        const int kc = idx & 63, g = (idx >> 6) & 3, part = (idx >> 8) & 1, k = (idx >> 9) & 1023, l = (int)(idx >> 19);
        const float* src = a.in[I_WIN] + ((size_t)l * 1024 + k) * 2048 + 1792 + 64 * g;
        float acc = 0.f;
        for (int c = 0; c < 64; ++c) { const int m = ((c * kc) & 63) * 64; const float tr = part ? -tab[(m - 1024) & 4095] : tab[m]; acc += src[c] * tr; }
        WIN[((size_t)l * NIN + 1792 + part * 256 + g * 64 + kc) * 1024 + k] = f2bf(acc);
    }
    for (size_t idx = gt; idx < (size_t)4 * 1024 * 192; idx += gn) {
        const int j = (int)(idx % 192), k = (int)((idx / 192) & 1023), l = (int)(idx / (192 * 1024));
        const float* W1; int R, jj, mi;
        if (j < 64) { mi = 3; R = 32; jj = j & 31; W1 = a.in[I_DW1] + ((size_t)l * 2 + (j >> 5)) * 256 * 32; }
        else if (j < 128) { mi = 4; R = 32; jj = j & 31; W1 = a.in[I_IA1] + ((size_t)l * 2 + ((j - 64) >> 5)) * 256 * 32; }
        else { mi = 5; R = 64; jj = j - 128; W1 = a.in[I_GG1] + (size_t)l * 256 * 64; }
        const float* mu = a.in[I_MU] + ((size_t)l * 6 + mi) * 256;
        const float* src = a.in[I_WIN] + ((size_t)l * 1024 + k) * 2048 + 1280;
        float pa = 0.f, pb = 0.f;
        for (int c = 0; c < 256; ++c) { const float wv = src[c] * W1[c * R + jj], m = mu[c]; pb = fmaf(wv, m, pb); pa = fmaf(wv, 1.0f - m, pa); }
        WIN[((size_t)l * NIN + 2304 + j) * 1024 + k] = f2bf(pa); WIN[((size_t)l * NIN + 2496 + j) * 1024 + k] = f2bf(pb);
    }
    for (size_t idx = gt; idx < (size_t)4 * 128 * 1024; idx += gn) { const int k = idx & 1023, r = (idx >> 10) & 127, l = (int)(idx >> 17); WIN[((size_t)l * NIN + 2688 + r) * 1024 + k] = 0; }
    for (size_t idx = gt; idx < (size_t)4 * 4 * 8 * 1024; idx += gn) {
        const int n = idx & 1023, c8 = (idx >> 10) & 7, g = (idx >> 13) & 3, l = (int)(idx >> 15);
        const float* pw = a.in[I_PW] + (((size_t)l * 4 + g) * 64 + c8 * 8) * 64;
        const float* ps = a.in[I_PS] + l * 256 + 64 * g;
        const float* wo = a.in[I_WOUT] + ((size_t)l * 1024 + 512 + 64 * g) * 1024 + n;
        float acc[8];
#pragma unroll
        for (int e = 0; e < 8; ++e) acc[e] = 0.f;
        for (int d = 0; d < 64; ++d) { const float w = wo[(size_t)d * 1024] * ps[d];
#pragma unroll
            for (int e = 0; e < 8; ++e) acc[e] += pw[e * 64 + d] * w; }
        bf16_t* dst = WOUT + ((size_t)l * 1024 + n) * 1024 + 512 + 64 * g + c8 * 8;
        u32x4v o; o.x = cvt_pk_bf16(acc[0], acc[1]); o.y = cvt_pk_bf16(acc[2], acc[3]); o.z = cvt_pk_bf16(acc[4], acc[5]); o.w = cvt_pk_bf16(acc[6], acc[7]);
        *(u32x4v*)dst = o;
    }
    for (size_t idx = gt; idx < (size_t)4 * 32 * 1024; idx += gn) {
        const int n = idx & 1023, i8 = (idx >> 10) & 31, l = (int)(idx >> 15);
        const float* fw = a.in[I_FW] + ((size_t)l * 256 + i8 * 8) * 256;
        const float* wo = a.in[I_WOUT] + ((size_t)l * 1024 + 768) * 1024 + n;
        float acc[8];
#pragma unroll
        for (int e = 0; e < 8; ++e) acc[e] = 0.f;
        for (int j = 0; j < 256; ++j) { const float w = wo[(size_t)j * 1024];
#pragma unroll
            for (int e = 0; e < 8; ++e) acc[e] += fw[e * 256 + j] * w; }
        bf16_t* dst = WOUT + ((size_t)l * 1024 + n) * 1024 + 768 + i8 * 8;
        u32x4v o; o.x = cvt_pk_bf16(acc[0], acc[1]); o.y = cvt_pk_bf16(acc[2], acc[3]); o.z = cvt_pk_bf16(acc[4], acc[5]); o.w = cvt_pk_bf16(acc[6], acc[7]);
        *(u32x4v*)dst = o;
    }
    {
        bf16_t* DFT = (bf16_t*)(ws + OFF_DFT); bf16_t* DFTC = (bf16_t*)(ws + OFF_DFTC);
        for (size_t idx = gt; idx < (size_t)4096 * 1024; idx += gn) {
            const int kt = (int)(idx >> 10), c8 = (int)(idx & 1023), part = c8 >> 9, t0 = (c8 & 511) * 8;
            float v[8];
#pragma unroll
            for (int e = 0; e < 8; ++e) { const int m = (kt * (t0 + e)) & 4095; v[e] = tab[part ? ((m - 1024) & 4095) : m] * (1.0f / 512.0f); }
            u32x4v o; o.x = cvt_pk_bf16(v[0], v[1]); o.y = cvt_pk_bf16(v[2], v[3]); o.z = cvt_pk_bf16(v[4], v[5]); o.w = cvt_pk_bf16(v[6], v[7]);
            *(u32x4v*)(DFT + (size_t)kt * 8192 + c8 * 8) = o;
        }
        for (size_t idx = gt; idx < (size_t)256 * 64; idx += gn) {
            const int kt = (int)(idx >> 6), c8 = (int)(idx & 63), part = c8 >> 5, t0 = (c8 & 31) * 8;
            float v[8];
#pragma unroll
            for (int e = 0; e < 8; ++e) { const int m = ((kt * (t0 + e)) & 255) * 16; v[e] = tab[part ? ((m - 1024) & 4095) : m] * (1.0f / 128.0f); }
            u32x4v o; o.x = cvt_pk_bf16(v[0], v[1]); o.y = cvt_pk_bf16(v[2], v[3]); o.z = cvt_pk_bf16(v[4], v[5]); o.w = cvt_pk_bf16(v[6], v[7]);
            *(u32x4v*)(DFTC + (size_t)kt * 512 + c8 * 8) = o;
        }
    }
    {
        float* MOD = (float*)(ws + OFF_MOD);
        float* red = sm + 4096 + 5120;
        const int col = tid & 63, kg = tid >> 6;
        for (int it = bx; it < 4 * 144; it += G) {
            const int l = it / 144, n0 = (it % 144) * 64;
            const float* w = a.in[I_WMOD] + ((size_t)l * 1024 + kg * 128) * 9216 + n0 + col;
            float acc[5] = {0.f, 0.f, 0.f, 0.f, 0.f};
            for (int k = 0; k < 128; ++k) { const float wv = w[(size_t)k * 9216];
#pragma unroll
                for (int s = 0; s < 5; ++s) acc[s] += sc[s * 1024 + kg * 128 + k] * wv; }
#pragma unroll
            for (int s = 0; s < 5; ++s) red[(kg * 5 + s) * 64 + col] = acc[s];
            __syncthreads();
            if (tid < 320) { const int s = tid >> 6; float t = a.in[I_BMOD][l * 9216 + n0 + col];
#pragma unroll
                for (int q = 0; q < 8; ++q) t += red[(q * 5 + s) * 64 + col];
                MOD[((size_t)l * 5 + s) * 9216 + n0 + col] = t; }
            __syncthreads();
        }
    }
}

__device__ void rowwise_phase(CArgs& a, int mode, int l, int sub, float resid_w, int nl, int nsub, bool final_out) {
    unsigned char* ws = a.ws;
    const float* MOD = (const float*)(ws + OFF_MOD);
    float* X = (float*)(ws + OFF_X); const float* Y = (const float*)(ws + OFF_Y); bf16_t* H = (bf16_t*)(ws + OFF_H);
    const int lane = tid_opq() & 63, wid = tid_opq() >> 6;
    for (int row = bx_opq() * 8 + wid; row < MT; row += gridDim.x * 8) {
        const int s = row < ML ? (row >> 12) : 4;
        f4v v[4];
        if (mode == 0) {
            const float* src = row < ML ? a.in[I_X] + (size_t)row * DM : a.in[I_CTX] + (size_t)(row - ML) * DM;
#pragma unroll
            for (int q = 0; q < 4; ++q) v[q] = *(const f4v*)(src + q * 256 + lane * 4);
        } else {
            const float* gate = MOD + ((size_t)l * 5 + s) * 9216 + (sub * 3 + 2) * 1024;
            float sum = 0.f;
#pragma unroll
            for (int q = 0; q < 4; ++q) { const int col = q * 256 + lane * 4;
                const f4v x = *(const f4v*)(X + (size_t)row * DM + col), y = *(const f4v*)(Y + (size_t)row * DM + col), g = *(const f4v*)(gate + col);
                v[q] = ALPHA * x + resid_w * (g * y); sum += (v[q].x + v[q].y) + (v[q].z + v[q].w); }
            const float mean = wsum(sum) * (1.0f / 1024.0f);
            float sq = 0.f;
#pragma unroll
            for (int q = 0; q < 4; ++q) { const f4v d = v[q] - mean; sq += (d.x * d.x + d.y * d.y) + (d.z * d.z + d.w * d.w); }
            const float rstd = rsqrtf(wsum(sq) * (1.0f / 1024.0f) + 1e-5f);
            const float* lg = a.in[I_LNG] + ((size_t)l * 3 + sub) * 1024; const float* lb = a.in[I_LNB] + ((size_t)l * 3 + sub) * 1024;
#pragma unroll
            for (int q = 0; q < 4; ++q) { const int col = q * 256 + lane * 4; v[q] = (v[q] - mean) * rstd * *(const f4v*)(lg + col) + *(const f4v*)(lb + col); }
        }
        if (final_out) { if (row < ML) {
#pragma unroll
            for (int q = 0; q < 4; ++q) *(f4v*)(a.out + (size_t)row * DM + q * 256 + lane * 4) = v[q]; } }
        else {
#pragma unroll
            for (int q = 0; q < 4; ++q) *(f4v*)(X + (size_t)row * DM + q * 256 + lane * 4) = v[q]; }
        if (nl >= 0) {
            const float* sh = MOD + ((size_t)nl * 5 + s) * 9216 + (nsub * 3 + 0) * 1024; const float* scl = sh + 1024;
#pragma unroll
            for (int q = 0; q < 4; ++q) { const int col = q * 256 + lane * 4; const f4v h = v[q] * (1.0f + *(const f4v*)(scl + col)) + *(const f4v*)(sh + col);
                u32x2v o; o.x = cvt_pk_bf16(h.x, h.y); o.y = cvt_pk_bf16(h.z, h.w); *(u32x2v*)(H + (size_t)row * DM + col) = o; }
        }
    }
}

__device__ void attn_prep(CArgs& a, int l, float* sm) {
    unsigned char* ws = a.ws;
    const bf16_t* Z = (const bf16_t*)(ws + OFF_Z);
    bf16_t* Q = (bf16_t*)(ws + OFF_Q); bf16_t* QC = (bf16_t*)(ws + OFF_QC); bf16_t* Kb = (bf16_t*)(ws + OFF_K); bf16_t* VT = (bf16_t*)(ws + OFF_VT);
    const int tid = tid_opq(), lane = tid & 63, slot = __builtin_amdgcn_readfirstlane(tid >> 6);
    float* tabc = sm; float* tabs = sm + 64 * 17;
    __syncthreads();
    for (int idx = tid; idx < 1024; idx += 512) { const int pos = idx >> 4, i = idx & 15;
        const float ang = (float)pos * exp2f(-(float)i * (13.287712379549449f / 16.0f));
        float sn, cs; sincosf(ang, &sn, &cs); tabc[pos * 17 + i] = cs; tabs[pos * 17 + i] = sn; }
    __syncthreads();
    const float* gp = slot < 4 ? a.in[I_QG] + l * 64 : a.in[I_KG] + l * 64;
    for (int tile = bx_opq(); tile < MT / 64; tile += gridDim.x) {
        const int row = tile * 64 + lane;
        const bool lat = tile < ML / 64;
        const int b = lat ? (row >> 12) : ((row - ML) >> 8), t = lat ? (row & 4095) : ((row - ML) & 255), pos = lat ? 256 + t : t;
        float x[64];
        const u32x4v* zp = (const u32x4v*)(Z + (size_t)row * ZW + slot * 64);
#pragma unroll
        for (int q = 0; q < 8; ++q) { const u32x4v w = zp[q];
            x[8 * q + 0] = __uint_as_float(w.x << 16); x[8 * q + 1] = __uint_as_float(w.x & 0xffff0000u); x[8 * q + 2] = __uint_as_float(w.y << 16); x[8 * q + 3] = __uint_as_float(w.y & 0xffff0000u);
            x[8 * q + 4] = __uint_as_float(w.z << 16); x[8 * q + 5] = __uint_as_float(w.z & 0xffff0000u); x[8 * q + 6] = __uint_as_float(w.w << 16); x[8 * q + 7] = __uint_as_float(w.w & 0xffff0000u); }
        if (slot < 6) {
            float ss = 0.f;
#pragma unroll
            for (int d = 0; d < 64; ++d) ss = fmaf(x[d], x[d], ss);
            const float sc = rsqrtf(ss * (1.0f / 64.0f) + 1e-6f) * (slot < 4 ? QSCALE : 1.0f);
#pragma unroll
            for (int d = 0; d < 64; ++d) x[d] *= sc * gp[d];
            if (lat) {
                const int rr = t >> 6, cc = t & 63;
#pragma unroll
                for (int i = 0; i < 32; ++i) { const int ti = (i < 16 ? rr : cc) * 17 + (i & 15); const float cs = tabc[ti], sn = tabs[ti];
                    const float x0 = x[2 * i], x1 = x[2 * i + 1]; x[2 * i] = x0 * cs - x1 * sn; x[2 * i + 1] = x0 * sn + x1 * cs; }
            }
            bf16_t* dst = slot < 4 ? (lat ? Q + ((size_t)(b * 4 + slot) * SEQ + t) * 64 : QC + ((size_t)(b * 4 + slot) * CTXL + t) * 64)
                                   : Kb + ((size_t)(b * 2 + (slot - 4)) * TK + pos) * 64;
#pragma unroll
            for (int q = 0; q < 8; ++q) { u32x4v w; w.x = cvt_pk_bf16(x[8 * q], x[8 * q + 1]); w.y = cvt_pk_bf16(x[8 * q + 2], x[8 * q + 3]);
                w.z = cvt_pk_bf16(x[8 * q + 4], x[8 * q + 5]); w.w = cvt_pk_bf16(x[8 * q + 6], x[8 * q + 7]); *(u32x4v*)(dst + 8 * q) = w; }
        } else {
            bf16_t* dst = VT + (size_t)(b * 2 + (slot - 6)) * 64 * TK + pos;
#pragma unroll
            for (int d = 0; d < 64; ++d) dst[(size_t)d * TK] = (bf16_t)(__float_as_uint(x[d]) >> 16);
        }
    }
    __syncthreads();
}

__device__ void pool_prep(CArgs& a) {
    unsigned char* ws = a.ws;
    const bf16_t* Z = (const bf16_t*)(ws + OFF_Z); bf16_t* CC = (bf16_t*)(ws + OFF_CONCAT);
    const int ch = tid_opq() & 255, g = ch >> 6, hw = 1 << g;
    for (int pr = bx_opq(); pr < MT / 2; pr += gridDim.x) {
        const int row = pr * 2 + (tid_opq() >> 8);
        const bool lat = row < ML;
        const int base = lat ? (row & ~4095) : (ML + ((row - ML) & ~255)), T = lat ? SEQ : CTXL, t = row - base;
        const int lo = t - hw < 0 ? 0 : t - hw, hi = t + hw > T ? T : t + hw;
        float sum = 0.f;
        for (int tt = lo; tt < hi; ++tt) sum += bf2f(Z[(size_t)(base + tt) * ZW + 1536 + ch]);
        const float zc = bf2f(Z[(size_t)row * ZW + 1536 + ch]);
        CC[(size_t)row * DM + 512 + ch] = f2bf(sum / (float)(hi - lo) - zc);
    }
}

__device__ void rwkv_prep(CArgs& a, int l, float* sm) {
    unsigned char* ws = a.ws;
    const bf16_t* Z = (const bf16_t*)(ws + OFF_Z);
    float* RW = (float*)(ws + OFF_RW); bf16_t* BON = (bf16_t*)(ws + OFF_BON); bf16_t* GG = (bf16_t*)(ws + OFF_G);
    float* Ps = sm;
    const bf16_t* PB = (const bf16_t*)(ws + OFF_PB);
    const int tid = tid_opq(), c = tid & 255, th = tid >> 8, h = c >> 6;
    const float* mu = a.in[I_MU] + (size_t)l * 6 * 256;
    const float mu0 = mu[c], mu1 = mu[256 + c], mu2 = mu[512 + c];
    const float kkc = a.in[I_KK][l * 256 + c], kac = a.in[I_KA][l * 256 + c], rkc = a.in[I_RK][l * 256 + c];
    const float w00 = a.in[I_DW0][(l * 2 + 0) * 256 + c], w01 = a.in[I_DW0][(l * 2 + 1) * 256 + c];
    const float a00 = a.in[I_IA0][(l * 2 + 0) * 256 + c], a01 = a.in[I_IA0][(l * 2 + 1) * 256 + c];
    const float* dw2 = a.in[I_DW2] + (size_t)l * 2 * 32 * 256; const float* ia2 = a.in[I_IA2] + (size_t)l * 2 * 32 * 256; const float* gg2 = a.in[I_GG2] + (size_t)l * 64 * 256;
    for (int tile = bx_opq(); tile < MT / 16; tile += gridDim.x) {
        const int row0 = tile * 16;
        const bool lat = row0 < ML;
        const int base = lat ? (row0 & ~4095) : (ML + ((row0 - ML) & ~255)), T = lat ? SEQ : CTXL;
#pragma unroll
        for (int i = 0; i < 6; ++i) {
            const int o = tid + 512 * i, ti = o / 192, j = o % 192, row = row0 + ti, t = row - base;
            const float pa = bf2f(PB[(size_t)row * 512 + j]);
            const float pp = t > 0 ? bf2f(PB[(size_t)(row - 1) * 512 + 192 + j]) : 0.f, pn = t < T - 1 ? bf2f(PB[(size_t)(row + 1) * 512 + 192 + j]) : 0.f;
            const float acc = pa + 0.5f * (pp + pn);
            Ps[ti * 192 + j] = j < 64 ? tanh_fast(acc) : (j < 128 ? acc : sigm(acc));
        }
        __syncthreads();
        float aw0[8], aw1[8], aa0[8], aa1[8], ag[8];
#pragma unroll
        for (int tt = 0; tt < 8; ++tt) { aw0[tt] = 0.f; aw1[tt] = 0.f; aa0[tt] = 0.f; aa1[tt] = 0.f; ag[tt] = 0.f; }
#pragma unroll 8
        for (int j = 0; j < 32; ++j) {
            const float w20 = dw2[(size_t)j * 256 + c], w21 = dw2[(size_t)(32 + j) * 256 + c], a20 = ia2[(size_t)j * 256 + c], a21 = ia2[(size_t)(32 + j) * 256 + c];
#pragma unroll
            for (int tt = 0; tt < 8; ++tt) { const float* p = Ps + (th * 8 + tt) * 192;
                aw0[tt] += p[j] * w20; aw1[tt] += p[32 + j] * w21; aa0[tt] += p[64 + j] * a20; aa1[tt] += p[96 + j] * a21; }
        }
#pragma unroll 8
        for (int j = 0; j < 64; ++j) { const float g2 = gg2[(size_t)j * 256 + c];
#pragma unroll
            for (int tt = 0; tt < 8; ++tt) ag[tt] += Ps[(th * 8 + tt) * 192 + 128 + j] * g2; }
#pragma unroll
        for (int tt = 0; tt < 8; ++tt) {
            const int row = row0 + th * 8 + tt, t = row - base;
            const bool hp = t > 0, hn = t < T - 1;
            const bf16_t* zc = Z + (size_t)row * ZW + c;
            const float rc = bf2f(zc[512]), kc = bf2f(zc[768]), vc = bf2f(zc[1024]);
            const float rp = hp ? bf2f(zc[512 - ZW]) : 0.f, kp = hp ? bf2f(zc[768 - ZW]) : 0.f, vp = hp ? bf2f(zc[1024 - ZW]) : 0.f;
            const float rn = hn ? bf2f(zc[512 + ZW]) : 0.f, kn = hn ? bf2f(zc[768 + ZW]) : 0.f, vn = hn ? bf2f(zc[1024 + ZW]) : 0.f;
            const float r = rc + (0.5f * (rp + rn) - rc) * mu0, k = kc + (0.5f * (kp + kn) - kc) * mu1, v = vc + (0.5f * (vp + vn) - vc) * mu2;
            float kk = k * kkc; const float nrm = sqrtf(wsum(kk * kk)); kk = kk * __builtin_amdgcn_rcpf(fmaxf(nrm, 1e-12f));
            float bsum = 0.f;
            const size_t o = (size_t)row * 256 + c;
#pragma unroll
            for (int d = 0; d < 2; ++d) {
                const float wraw = (d ? w01 : w00) + (d ? aw1[tt] : aw0[tt]);
                const float decay = __builtin_amdgcn_exp2f(-0.8750387749924077f * sigm(wraw));
                const float ai = sigm((d ? a01 : a00) + (d ? aa1[tt] : aa0[tt]));
                const float kd = k * (1.0f + (ai - 1.0f) * kac);
                RW[(size_t)(RW_W0 + d) * RWA + o] = decay; RW[(size_t)(RW_KD0 + d) * RWA + o] = kd; RW[(size_t)(RW_B0 + d) * RWA + o] = kk * ai;
                bsum += wsum(r * kd * rkc);
            }
            RW[(size_t)RW_R * RWA + o] = r; RW[(size_t)RW_V * RWA + o] = v; RW[(size_t)RW_KK * RWA + o] = kk;
            BON[o] = f2bf(bsum * v); GG[o] = f2bf(ag[tt]);
        }
        __syncthreads();
    }
}

__device__ __forceinline__ int seqrow(int dir, int b, int s) {
    if (s < CTXL) return ML + b * CTXL + (dir ? CTXL - 1 - s : s);
    const int t = s - CTXL; return b * SEQ + (dir ? SEQ - 1 - t : t);
}
__device__ __forceinline__ float rdl(float v, int k) { return __int_as_float(__builtin_amdgcn_readlane(__float_as_int(v), k)); }
template <bool DOP, bool DOU, bool EMIT>
__device__ __forceinline__ void scan_steps(float (&sp)[64], float (&su)[64], int dir, int b, int h, int s0, int ns, const float* KK, const float* Wd, const float* Bd, const float* KDd,
                                           const float* Vv, const float* Rr, float* Yd, int lane) {
    size_t off = (size_t)seqrow(dir, b, s0) * 256 + h * 64 + lane;
    float xk = KK[off], xw = Wd[off], xb = Bd[off], xd = DOU ? KDd[off] : 0.f, xv = DOU ? Vv[off] : 0.f, xr = EMIT ? Rr[off] : 0.f;
#pragma unroll 1
    for (int s = s0; s < s0 + ns; ++s) {
        const size_t offc = off;
        const float ck = xk, cw = xw, cb = xb, cd = xd, cv = xv, cr = xr;
        if (s + 1 < s0 + ns) {
            off = (size_t)seqrow(dir, b, s + 1) * 256 + h * 64 + lane;
            xk = KK[off]; xw = Wd[off]; xb = Bd[off]; if (DOU) { xd = KDd[off]; xv = Vv[off]; } if (EMIT) xr = Rr[off];
        }
        float pa0 = 0.f, pa1 = 0.f, ua0 = 0.f, ua1 = 0.f;
#pragma unroll
        for (int k = 0; k < 64; k += 2) { const float k0 = rdl(ck, k), k1 = rdl(ck, k + 1);
            if (DOP) { pa0 = fmaf(sp[k], k0, pa0); pa1 = fmaf(sp[k + 1], k1, pa1); }
            if (DOU) { ua0 = fmaf(su[k], k0, ua0); ua1 = fmaf(su[k + 1], k1, ua1); } }
        const float sap = -(pa0 + pa1), sau = -(ua0 + ua1);
        float y0 = 0.f, y1 = 0.f;
#pragma unroll
        for (int k = 0; k < 64; k += 2) {
            const float w0 = rdl(cw, k), w1 = rdl(cw, k + 1), b0 = rdl(cb, k), b1 = rdl(cb, k + 1);
            if (DOP) { sp[k] = fmaf(sp[k], w0, sap * b0); sp[k + 1] = fmaf(sp[k + 1], w1, sap * b1); }
            if (DOU) { const float d0 = rdl(cd, k), d1 = rdl(cd, k + 1);
                const float n0 = fmaf(cv, d0, fmaf(su[k], w0, sau * b0)), n1 = fmaf(cv, d1, fmaf(su[k + 1], w1, sau * b1));
                su[k] = n0; su[k + 1] = n1;
                if (EMIT) { y0 = fmaf(n0, rdl(cr, k), y0); y1 = fmaf(n1, rdl(cr, k + 1), y1); } }
        }
        if (EMIT) Yd[offc] = y0 + y1;
    }
}

__device__ void scan_pass1(CArgs& a) {
    unsigned char* ws = a.ws;
    const float* RW = (const float*)(ws + OFF_RW);
    float* PST = (float*)(ws + OFF_PST); float* UST = (float*)(ws + OFF_UST);
    const int tid = tid_opq(), lane = tid & 63, wid = __builtin_amdgcn_readfirstlane(tid >> 6);
    if (wid >= 4) return;
    for (int task = bx_opq() * 4 + wid; task < 32 * (NCH - 1); task += gridDim.x * 4) {
        const int c = task % (NCH - 1), seq = task / (NCH - 1), dir = seq >> 4, bh = seq & 15, b = bh >> 2, h = bh & 3;
        float sp[64], su[64];
#pragma unroll
        for (int k = 0; k < 64; ++k) { sp[k] = (k == lane) ? 1.f : 0.f; su[k] = 0.f; }
        scan_steps<true, true, false>(sp, su, dir, b, h, c * CHL, CHL, RW + (size_t)RW_KK * RWA, RW + (size_t)(RW_W0 + dir) * RWA, RW + (size_t)(RW_B0 + dir) * RWA,
                                      RW + (size_t)(RW_KD0 + dir) * RWA, RW + (size_t)RW_V * RWA, RW, nullptr, lane);
        float* dp = PST + ((size_t)(seq * NCH + c) * 64 + lane) * 64; float* du = UST + ((size_t)(seq * NCH + c) * 64 + lane) * 64;
#pragma unroll
        for (int q = 0; q < 16; ++q) { f4v o; o.x = sp[4 * q]; o.y = sp[4 * q + 1]; o.z = sp[4 * q + 2]; o.w = sp[4 * q + 3]; *(f4v*)(dp + 4 * q) = o;
            f4v p; p.x = su[4 * q]; p.y = su[4 * q + 1]; p.z = su[4 * q + 2]; p.w = su[4 * q + 3]; *(f4v*)(du + 4 * q) = p; }
    }
}

__device__ void scan_pass2(CArgs& a, float* sm) {
    unsigned char* ws = a.ws;
    const float* PST = (const float*)(ws + OFF_PST); const float* UST = (const float*)(ws + OFF_UST); float* SST = (float*)(ws + OFF_SST);
    float* S = sm;
    float* Pm = sm + 64 * 65;
    const int tid = tid_opq(), i = tid >> 3, kq = tid & 7;
    for (int seq = bx_opq(); seq < 32; seq += gridDim.x) {
        __syncthreads();
        { const float* u0 = UST + (size_t)(seq * NCH + 0) * 4096 + i * 64 + kq * 8; float* d = SST + (size_t)(seq * NCH + 1) * 4096 + i * 64 + kq * 8;
#pragma unroll
          for (int e = 0; e < 8; ++e) { const float v = u0[e]; S[i * 65 + kq * 8 + e] = v; d[e] = v; } }
        for (int c = 1; c < NCH - 1; ++c) {
            const float* P = PST + (size_t)(seq * NCH + c) * 4096;
#pragma unroll
            for (int e = 0; e < 8; ++e) Pm[tid * 8 + e] = P[tid * 8 + e];
            __syncthreads();
            const float* uc = UST + (size_t)(seq * NCH + c) * 4096 + i * 64 + kq * 8;
            float acc[8];
#pragma unroll
            for (int e = 0; e < 8; ++e) acc[e] = uc[e];
            for (int j = 0; j < 64; ++j) { const float sv = S[i * 65 + j];
#pragma unroll
                for (int e = 0; e < 8; ++e) acc[e] = fmaf(sv, Pm[j * 64 + kq * 8 + e], acc[e]); }
            __syncthreads();
            float* d = SST + (size_t)(seq * NCH + c + 1) * 4096 + i * 64 + kq * 8;
#pragma unroll
            for (int e = 0; e < 8; ++e) { S[i * 65 + kq * 8 + e] = acc[e]; d[e] = acc[e]; }
            __syncthreads();
        }
    }
}

__device__ void scan_pass3(CArgs& a) {
    unsigned char* ws = a.ws;
    const float* RW = (const float*)(ws + OFF_RW);
    const float* SST = (const float*)(ws + OFF_SST); float* YS = (float*)(ws + OFF_YS);
    const int tid = tid_opq(), lane = tid & 63, wid = __builtin_amdgcn_readfirstlane(tid >> 6);
    if (wid >= 4) return;
    for (int task = bx_opq() * 4 + wid; task < 32 * NCH; task += gridDim.x * 4) {
        const int c = task % NCH, seq = task / NCH, dir = seq >> 4, bh = seq & 15, b = bh >> 2, h = bh & 3;
        float st[64];
        if (c == 0) {
#pragma unroll
            for (int k = 0; k < 64; ++k) st[k] = 0.f;
        } else { const float* src = SST + ((size_t)(seq * NCH + c) * 64 + lane) * 64;
#pragma unroll
            for (int q = 0; q < 16; ++q) { const f4v v = *(const f4v*)(src + 4 * q); st[4 * q] = v.x; st[4 * q + 1] = v.y; st[4 * q + 2] = v.z; st[4 * q + 3] = v.w; } }
        scan_steps<false, true, true>(st, st, dir, b, h, c * CHL, CHL, RW + (size_t)RW_KK * RWA, RW + (size_t)(RW_W0 + dir) * RWA, RW + (size_t)(RW_B0 + dir) * RWA,
                                      RW + (size_t)(RW_KD0 + dir) * RWA, RW + (size_t)RW_V * RWA, RW + (size_t)RW_R * RWA, YS + (size_t)dir * RWA, lane);
    }
}

__device__ void finalize_phase(CArgs& a, int l) {
    unsigned char* ws = a.ws;
    const float* YS = (const float*)(ws + OFF_YS); const bf16_t* BON = (const bf16_t*)(ws + OFF_BON); const bf16_t* GG = (const bf16_t*)(ws + OFF_G);
    const float* PART = (const float*)(ws + OFF_PART); const float* PARTC = (const float*)(ws + OFF_PARTC); bf16_t* CC = (bf16_t*)(ws + OFF_CONCAT);
    const int ch = tid_opq() & 255;
    const float gng = a.in[I_GNG][l * 256 + ch], gnb = a.in[I_GNB][l * 256 + ch];
    for (int pr = bx_opq(); pr < MT / 2; pr += gridDim.x) {
        const int row = pr * 2 + (tid_opq() >> 8);
        const size_t o = (size_t)row * 256 + ch;
        const float y = YS[o] + YS[RWA + o];
        const float mean = wsum(y) * (1.0f / 64.0f), d = y - mean, var = wsum(d * d) * (1.0f / 64.0f);
        const float yn = d * rsqrtf(var + 64e-5f) * gng + gnb;
        CC[(size_t)row * DM + 256 + ch] = f2bf((yn + bf2f(BON[o])) * bf2f(GG[o]));
        float f;
        if (row < ML) { const int b = row >> 12, kt = row & 4095; const float* p = PART + (size_t)kt * 1024 + b * 256 + ch;
            f = (p[0] + p[(size_t)4096 * 1024]) + (p[(size_t)2 * 4096 * 1024] + p[(size_t)3 * 4096 * 1024]); }
        else { const int rr = row - ML, b = rr >> 8, kt = rr & 255; f = PARTC[(size_t)kt * 1024 + b * 256 + ch]; }
        CC[(size_t)row * DM + 768 + ch] = f2bf(f);
    }
}

__device__ void attn_phase(CArgs& a, int l, unsigned char* lds, int rep) {
    unsigned char* ws = a.ws;
    const bf16_t* Q = (const bf16_t*)(ws + OFF_Q); const bf16_t* QC = (const bf16_t*)(ws + OFF_QC); const bf16_t* Kb = (const bf16_t*)(ws + OFF_K); const bf16_t* VT = (const bf16_t*)(ws + OFF_VT);
    bf16_t* CC = (bf16_t*)(ws + OFF_CONCAT);
    unsigned* ctr = (unsigned*)(ws + OFF_CTL) + l + 8 * rep;
    bf16_t* Ks = (bf16_t*)lds;
    bf16_t* Vs = (bf16_t*)(lds + 64 * 72 * 2);
    volatile int* qslot = (volatile int*)(lds + 2 * 64 * 72 * 2);
    const int tid = tid_opq(), lane = tid & 63, wid = tid >> 6, lq = lane & 15, quad = lane >> 4;
    const int sr = tid >> 3, sc8 = (tid & 7) * 8;
    for (;;) {
        __syncthreads();
        if (tid == 0) *qslot = (int)atomicAdd(ctr, 1u);
        __syncthreads();
        const int u = *qslot;
        if (u >= 544) break;
        int b, hq, t0, nt, orow; const bf16_t* qp;
        if (u < 512) { b = u >> 7; hq = (u >> 5) & 3; t0 = (u & 31) * 128; nt = TK / 64; qp = Q + ((size_t)(b * 4 + hq) * SEQ + t0) * 64; orow = b * SEQ + t0; }
        else { const int uu = u - 512; b = uu >> 3; hq = (uu >> 1) & 3; t0 = (uu & 1) * 128; nt = CTXL / 64; qp = QC + ((size_t)(b * 4 + hq) * CTXL + t0) * 64; orow = ML + b * CTXL + t0; }
        const int kvh = hq >> 1;
        const bf16_t* kp = Kb + (size_t)(b * 2 + kvh) * TK * 64; const bf16_t* vp = VT + (size_t)(b * 2 + kvh) * 64 * TK;
        s16x8 qf[2];
#pragma unroll
        for (int ds = 0; ds < 2; ++ds) qf[ds] = *(const s16x8*)(qp + (size_t)(wid * 16 + lq) * 64 + ds * 32 + quad * 8);
        f4v o[4];
#pragma unroll
        for (int db = 0; db < 4; ++db) o[db] = (f4v){0.f, 0.f, 0.f, 0.f};
        float mrun = -1e30f, lrun = 0.f;
        u32x4v kreg = *(const u32x4v*)(kp + (size_t)sr * 64 + sc8), vreg = *(const u32x4v*)(vp + (size_t)sr * TK + sc8);
        for (int kt = 0; kt < nt; ++kt) {
            __syncthreads();
            *(u32x4v*)(Ks + sr * 72 + sc8) = kreg; *(u32x4v*)(Vs + sr * 72 + sc8) = vreg;
            __syncthreads();
            if (kt + 1 < nt) { kreg = *(const u32x4v*)(kp + (size_t)((kt + 1) * 64 + sr) * 64 + sc8); vreg = *(const u32x4v*)(vp + (size_t)sr * TK + (kt + 1) * 64 + sc8); }
            f4v s[4];
#pragma unroll
            for (int nb = 0; nb < 4; ++nb) {
                f4v acc = (f4v){0.f, 0.f, 0.f, 0.f};
#pragma unroll
                for (int ds = 0; ds < 2; ++ds) { const s16x8 kf = *(const s16x8*)(Ks + (nb * 16 + lq) * 72 + ds * 32 + quad * 8);
                    acc = __builtin_amdgcn_mfma_f32_16x16x32_bf16(kf, qf[ds], acc, 0, 0, 0); }
                s[nb] = acc;
            }
            float mx = fmaxf(fmaxf(s[0].x, s[0].y), fmaxf(s[0].z, s[0].w));
#pragma unroll
            for (int nb = 1; nb < 4; ++nb) mx = fmaxf(mx, fmaxf(fmaxf(s[nb].x, s[nb].y), fmaxf(s[nb].z, s[nb].w)));
            mx = fmaxf(mx, __shfl_xor(mx, 16)); mx = fmaxf(mx, __shfl_xor(mx, 32));
            const float mnew = fmaxf(mrun, mx), alpha = __builtin_amdgcn_exp2f(mrun - mnew); mrun = mnew;
            float ls = 0.f;
#pragma unroll
            for (int nb = 0; nb < 4; ++nb) { s[nb].x = __builtin_amdgcn_exp2f(s[nb].x - mnew); s[nb].y = __builtin_amdgcn_exp2f(s[nb].y - mnew);
                s[nb].z = __builtin_amdgcn_exp2f(s[nb].z - mnew); s[nb].w = __builtin_amdgcn_exp2f(s[nb].w - mnew); ls += (s[nb].x + s[nb].y) + (s[nb].z + s[nb].w); }
            lrun = lrun * alpha + ls;
#pragma unroll
            for (int db = 0; db < 4; ++db) o[db] *= alpha;
#pragma unroll
            for (int k2 = 0; k2 < 2; ++k2) {
                u32x4v pw; pw.x = cvt_pk_bf16(s[2 * k2].x, s[2 * k2].y); pw.y = cvt_pk_bf16(s[2 * k2].z, s[2 * k2].w);
                pw.z = cvt_pk_bf16(s[2 * k2 + 1].x, s[2 * k2 + 1].y); pw.w = cvt_pk_bf16(s[2 * k2 + 1].z, s[2 * k2 + 1].w);
                const s16x8 pf = __builtin_bit_cast(s16x8, pw);
#pragma unroll
                for (int db = 0; db < 4; ++db) {
                    const bf16_t* vr = Vs + (db * 16 + lq) * 72 + quad * 4;
                    const u32x2v v0 = *(const u32x2v*)(vr + (2 * k2) * 16), v1 = *(const u32x2v*)(vr + (2 * k2 + 1) * 16);
                    u32x4v vw; vw.x = v0.x; vw.y = v0.y; vw.z = v1.x; vw.w = v1.y;
                    o[db] = __builtin_amdgcn_mfma_f32_16x16x32_bf16(__builtin_bit_cast(s16x8, vw), pf, o[db], 0, 0, 0);
                }
            }
        }
        lrun += __shfl_xor(lrun, 16); lrun += __shfl_xor(lrun, 32);
        const float il = 1.0f / lrun;
        bf16_t* op = CC + (size_t)(orow + wid * 16 + lq) * DM + hq * 64 + quad * 4;
#pragma unroll
        for (int db = 0; db < 4; ++db) { u32x2v w; w.x = cvt_pk_bf16(o[db].x * il, o[db].y * il); w.y = cvt_pk_bf16(o[db].z * il, o[db].w * il); *(u32x2v*)(op + db * 16) = w; }
    }
}

#define XB_TMO      128
#define XB_XCNT(j)  (256  + 64 * (j))
#define XB_XSUB(j)  (1280 + 64 * (j))
#define XB_XGEN(j)  (2304 + 64 * (j))
#define XB_TOP      3328
#define XB_TOPGEN   3392
#define XCD_BAR_WORDS 3456
#define XB_SPIN_CAP (1u << 18)

__device__ __forceinline__ unsigned xb_ld(unsigned* p)              { return __hip_atomic_load(p, __ATOMIC_RELAXED, __HIP_MEMORY_SCOPE_AGENT); }
__device__ __forceinline__ unsigned xb_add(unsigned* p, unsigned v) { return __hip_atomic_fetch_add(p, v, __ATOMIC_RELAXED, __HIP_MEMORY_SCOPE_AGENT); }
__device__ __forceinline__ unsigned xb_xcc_id() { return (unsigned)__builtin_amdgcn_s_getreg((3 << 11) | 20) & 0xFu; }
#define XB_SPIN(cond, bar) do { unsigned _sp = 0; while (cond) { __builtin_amdgcn_s_sleep(1); \
    if ((++_sp & 255u) == 0u) { if (xb_ld(&(bar)[XB_TMO])) break; if (_sp > XB_SPIN_CAP) { atomicAdd(&(bar)[XB_TMO], 1u); break; } } } } while (0)

struct XcdBarrier {
    unsigned* bar; unsigned x;
    volatile LAS unsigned* st;
};

__device__ __forceinline__ XcdBarrier xcd_barrier_post(unsigned* bar, volatile LAS unsigned* st) {
    XcdBarrier b; b.bar = bar; b.x = xb_xcc_id(); b.st = st;
    if (threadIdx.x == 0) (void)xb_add(&bar[XB_XCNT(b.x)], 1u);
    return b;
}
__device__ __forceinline__ void xcd_barrier_complete(unsigned* bar, unsigned x, unsigned& nloc, unsigned& nx) {
    const unsigned G = gridDim.x * gridDim.y * gridDim.z;
    unsigned sum, cnt, mine, sp = 0u;
    for (;;) {
        sum = 0u; cnt = 0u; mine = 0u;
#pragma unroll
        for (unsigned j = 0; j < 16; ++j) { const unsigned c = xb_ld(&bar[XB_XCNT(j)]); sum += c; cnt += (c > 0u) ? 1u : 0u; mine = (j == x) ? c : mine; }
        if (sum == G) break;
        __builtin_amdgcn_s_sleep(1);
        if ((++sp & 255u) == 0u) { if (xb_ld(&bar[XB_TMO])) break; if (sp > XB_SPIN_CAP) { atomicAdd(&bar[XB_TMO], 1u); break; } }
    }
    nloc = mine > 0u ? mine : 1u; nx = cnt > 0u ? cnt : 1u;
}

__device__ __forceinline__ void xcd_barrier(const XcdBarrier& b) {
    asm volatile("s_waitcnt vmcnt(0)" ::: "memory");
    __syncthreads();
    if (threadIdx.x == 0) {
        unsigned* bar = b.bar;
        __builtin_amdgcn_s_waitcnt(0);
        unsigned nloc = b.st[0], nx = b.st[1];
        if (nloc == 0u) { xcd_barrier_complete(bar, b.x, nloc, nx); b.st[0] = nloc; b.st[1] = nx; }
        const unsigned old = xb_add(&bar[XB_XSUB(b.x)], 1u);
        const unsigned gen = old / nloc;
        if (old + 1u == (gen + 1u) * nloc) {
            __builtin_amdgcn_fence(__ATOMIC_RELEASE, "agent");
            asm volatile("s_waitcnt vmcnt(0)" ::: "memory");
            const unsigned og = xb_add(&bar[XB_TOP], 1u);
            const unsigned tg = og / nx;
            if (og + 1u == (tg + 1u) * nx) xb_add(&bar[XB_TOPGEN], 1u);
            else XB_SPIN(xb_ld(&bar[XB_TOPGEN]) == tg, bar);
            __builtin_amdgcn_fence(__ATOMIC_ACQUIRE, "agent");
            xb_add(&bar[XB_XGEN(b.x)], 1u);
            asm volatile("s_waitcnt vmcnt(0)" ::: "memory");
        } else {
            XB_SPIN(xb_ld(&bar[XB_XGEN(b.x)]) == gen, bar);
            __builtin_amdgcn_fence(__ATOMIC_ACQUIRE, "agent");
            asm volatile("s_waitcnt vmcnt(0)" ::: "memory");
        }
    }
    __syncthreads();
}

#define REP_GEMM 1
#define REP_PREP 1
#define REP_PA 1
#define REP_PP 1
#define REP_PR 1
#define REP_SCAN 1
#define REP_ATTN 1
#define REP_MISC 1
#define REP_PRO 1
#define REP_SYNC 1
#define REPEAT(n) for (int rep_ = 0; rep_ < (n); ++rep_)
__global__ void __launch_bounds__(512, 2) mega_fwd(Args a_unused) {
    extern __shared__ __attribute__((aligned(16))) unsigned char lds[];
    cg::grid_group grid = cg::this_grid();
    volatile LAS unsigned* bst = (volatile LAS unsigned*)((LAS unsigned char*)lds + 140000);
    if (tid_opq() == 0) { bst[0] = 0u; bst[1] = 0u; }
    __syncthreads();
    const XcdBarrier xbar = xcd_barrier_post((unsigned*)(KA.ws + OFF_CTL) + CTL_BAR, bst);
    float* sm = (float*)lds;
    PG8_LAS unsigned char* l3 = (PG8_LAS unsigned char*)lds;
    const int lo = KA.ph_lo, hi = KA.ph_hi;
#define G ((int)gridDim.x)
#define bx (bx_opq())
#define ws (KA.ws)
    int ph = 0;
#define PH_BEGIN if (ph >= lo && ph < hi) {
#define PH_END } ++ph; if (ph > lo && ph < hi) REPEAT(REP_SYNC) { if (ph == 1) grid.sync(); else xcd_barrier(xbar); }
#define H ((bf16_t*)(ws + OFF_H))
#define HID ((bf16_t*)(ws + OFF_HID))
#define Y ((float*)(ws + OFF_Y))

    PH_BEGIN REPEAT(REP_PRO) { prologue_a(KA, sm); } PH_END
    PH_BEGIN rowwise_phase(KA, 0, 0, 0, 0.f, 0, 0, false); PH_END
#pragma unroll 1
    for (int l = 0; l < DEPTH; ++l) {
#pragma unroll 1
        for (int f = 0; f < 2; ++f) {
            if (f == 1) {
                PH_BEGIN REPEAT(REP_GEMM) { pg8::Gemm g{H, (const bf16_t*)(ws + OFF_WIN) + (size_t)l * NIN * 1024, 1024, 1024, 1024}; pg8::StaticOrder S; S.init(MT, NIN, 1, G, bx);
                    pg8::EpiWin E{(bf16_t*)(ws + OFF_Z), (bf16_t*)(ws + OFF_ZT), (bf16_t*)(ws + OFF_ZTC), (bf16_t*)(ws + OFF_PB)};
                    pg8::gemm_phase<pg8::EpiWin, pg8::StaticOrder, true, true>(l3, g, S, E); } PH_END
                PH_BEGIN REPEAT(REP_PREP) { REPEAT(REP_PA) attn_prep(KA, l, sm); REPEAT(REP_PP) pool_prep(KA); REPEAT(REP_PR) rwkv_prep(KA, l, sm); } PH_END
                PH_BEGIN REPEAT(REP_SCAN) { scan_pass1(KA); } __syncthreads(); REPEAT(REP_GEMM) {
                    { pg8::Gemm g{(const bf16_t*)(ws + OFF_DFT), (const bf16_t*)(ws + OFF_ZT), 8192, 8192, 2048}; pg8::StaticOrder S; S.init(SEQ, 1024, 4, G, bx);
                      pg8::EpiF32 E{(float*)(ws + OFF_PART), 1024, (size_t)SEQ * 1024};
                      pg8::gemm_phase<pg8::EpiF32, pg8::StaticOrder, true, true>(l3, g, S, E); }
                    { pg8::Gemm g{(const bf16_t*)(ws + OFF_DFTC), (const bf16_t*)(ws + OFF_ZTC), 512, 512, 512}; pg8::StaticOrder S; S.init(CTXL, 1024, 1, G, bx);
                      pg8::EpiF32 E{(float*)(ws + OFF_PARTC), 1024, 0};
                      pg8::gemm_phase<pg8::EpiF32, pg8::StaticOrder, true, true>(l3, g, S, E); } } PH_END
                PH_BEGIN REPEAT(REP_MISC) { scan_pass2(KA, sm); } REPEAT(REP_ATTN) { attn_phase(KA, l, lds, rep_); } PH_END
                PH_BEGIN REPEAT(REP_SCAN) { scan_pass3(KA); } PH_END
                PH_BEGIN REPEAT(REP_MISC) { finalize_phase(KA, l); } PH_END
                PH_BEGIN REPEAT(REP_GEMM) { pg8::Gemm g{(const bf16_t*)(ws + OFF_CONCAT), (const bf16_t*)(ws + OFF_WOUT) + (size_t)l * 1024 * 1024, 1024, 1024, 1024}; pg8::StaticOrder S; S.init(MT, 1024, 1, G, bx);
                    pg8::EpiF32 E{Y, 1024, 0};
                    pg8::gemm_phase<pg8::EpiF32, pg8::StaticOrder, true, true>(l3, g, S, E); } PH_END
                PH_BEGIN rowwise_phase(KA, 1, l, 1, 1.0f, l, 2, false); PH_END
            }
            PH_BEGIN REPEAT(REP_GEMM) { pg8::Gemm g{H, (const bf16_t*)(ws + OFF_WGU) + (size_t)(l * 2 + f) * 5632 * 1024, 1024, 1024, 1024}; pg8::StaticOrder S; S.init(MT, 5632, 1, G, bx);
                pg8::EpiSwiglu E{HID, DFF};
                pg8::gemm_phase<pg8::EpiSwiglu, pg8::StaticOrder, true, true>(l3, g, S, E); } PH_END
            PH_BEGIN REPEAT(REP_GEMM) { pg8::Gemm g{HID, (const bf16_t*)(ws + OFF_WDN) + (size_t)(l * 2 + f) * 1024 * 2816, 2816, 2816, 2816}; pg8::StaticOrder S; S.init(MT, 1024, 1, G, bx);
                pg8::EpiF32 E{Y, 1024, 0};
                pg8::gemm_phase<pg8::EpiF32, pg8::StaticOrder, true, true>(l3, g, S, E); } PH_END
            PH_BEGIN if (f == 0) rowwise_phase(KA, 1, l, 0, 0.5f, l, 1, false);
                     else rowwise_phase(KA, 1, l, 2, 0.5f, l + 1 < DEPTH ? l + 1 : -1, 0, l + 1 == DEPTH); PH_END
        }
    }
#undef PH_BEGIN
#undef PH_END
#undef G
#undef bx
#undef ws
#undef H
#undef HID
#undef Y
}

constexpr int N_PHASES = 2 + DEPTH * 14;
#ifndef MK_PER_PHASE
#define MK_PER_PHASE 0
#endif

extern "C" void kernel_launch(void* const* d_in, const int* in_sizes, int n_in, void* d_out, int out_size, void* d_ws, size_t ws_size, hipStream_t stream) {
    static int grid = 0;
    if (grid == 0) {
        if (n_in != 31 || ws_size < WS_END) { fprintf(stderr, "kernel_launch: need 31 inputs and %zu bytes of workspace (got %d, %zu)\n", (size_t)WS_END, n_in, ws_size); grid = -1; return; }
        int dev = 0, cus = 0, per_cu = 0;
        hipGetDevice(&dev); hipDeviceGetAttribute(&cus, hipDeviceAttributeMultiprocessorCount, dev);
        if (hipFuncSetAttribute((const void*)mega_fwd, hipFuncAttributeMaxDynamicSharedMemorySize, LDS_BYTES) != hipSuccess) { fprintf(stderr, "kernel_launch: hipFuncSetAttribute failed\n"); grid = -1; return; }
        hipOccupancyMaxActiveBlocksPerMultiprocessor(&per_cu, (const void*)mega_fwd, 512, LDS_BYTES);
        (void)hipGetLastError();
        if (per_cu < 1) fprintf(stderr, "kernel_launch: occupancy query says %d blocks per CU\n", per_cu);
        grid = cus > 0 ? cus : 256;
    }
    if (grid < 0) return;
    if (hipMemsetAsync((char*)d_ws + OFF_CTL, 0, CTL_ZERO_BYTES, stream) != hipSuccess) { fprintf(stderr, "kernel_launch: memset of the control words failed\n"); return; }
    Args a{};
    for (int i = 0; i < 31; ++i) a.in[i] = (const float*)d_in[i];
    a.out = (float*)d_out; a.ws = (unsigned char*)d_ws;
#if MK_PER_PHASE
    for (int p = 0; p < N_PHASES; ++p) { a.ph_lo = p; a.ph_hi = p + 1; void* args[] = {&a};
        hipError_t e = hipLaunchCooperativeKernel((const void*)mega_fwd, dim3(grid), dim3(512), args, LDS_BYTES, stream);
        if (e != hipSuccess) { fprintf(stderr, "launch %d failed: %s\n", p, hipGetErrorString(e)); break; } }
#else
    a.ph_lo = 0; a.ph_hi = N_PHASES;
    void* args[] = {&a};
    hipError_t e = hipLaunchCooperativeKernel((const void*)mega_fwd, dim3(grid), dim3(512), args, LDS_BYTES, stream);
    if (e != hipSuccess) fprintf(stderr, "cooperative launch failed: %s (grid %d)\n", hipGetErrorString(e), grid);
#endif
}
```
